# Optimizing an MI355X kernel written in HIP

```python
import math
import jax, jax.numpy as jnp
from jax import lax
import numpy as np

D_MODEL = 1024
BATCH = 2
SEQ = 16384
DEPTH = 4

CHUNK = 128
N_SGU_GROUPS = 8
SGU_WIDTH = D_MODEL
SGU_GROUP = SGU_WIDTH // N_SGU_GROUPS
DIFF_HEAD_DIM = 64
N_DIFF_HEADS = D_MODEL // (2 * DIFF_HEAD_DIM)
DIFF_QK_WIDTH = N_DIFF_HEADS * 2 * DIFF_HEAD_DIM
DIFF_V_WIDTH = N_DIFF_HEADS * 2 * DIFF_HEAD_DIM
Q_BLOCK = 128
ROPE_THETA = 10000.0
N_BRANCH = 2
IN_WIDTH = 2 * SGU_WIDTH + 2 * DIFF_QK_WIDTH + DIFF_V_WIDTH + N_BRANCH * D_MODEL
SPLITS = [SGU_WIDTH, 2 * SGU_WIDTH, 2 * SGU_WIDTH + DIFF_QK_WIDTH,
          2 * SGU_WIDTH + 2 * DIFF_QK_WIDTH,
          2 * SGU_WIDTH + 2 * DIFF_QK_WIDTH + DIFF_V_WIDTH]
D_FF = 2816
ALPHA = (2.0 * DEPTH) ** 0.25
BETA = (8.0 * DEPTH) ** -0.25
LN_EPS = 1e-5

kernel_name = "hybrid_sgu_diffattn_macaron_deepnorm"


def _lambda_init(layer):
    return 0.8 - 0.6 * math.exp(-0.3 * layer)


def _layernorm(x, g, b):
    xf = x.astype(jnp.float32)
    mu = jnp.mean(xf, axis=-1, keepdims=True)
    var = jnp.mean(jnp.square(xf - mu), axis=-1, keepdims=True)
    y = (xf - mu) * lax.rsqrt(var + LN_EPS)
    return (y * g.astype(jnp.float32) + b.astype(jnp.float32)).astype(x.dtype)


def _rmsnorm(x, g):
    xf = x.astype(jnp.float32)
    y = xf * lax.rsqrt(jnp.mean(jnp.square(xf), axis=-1, keepdims=True) + LN_EPS)
    return (y * g.astype(jnp.float32)).astype(x.dtype)


def _swiglu(x, w1, w3, w2):
    return (jax.nn.silu(x @ w1) * (x @ w3)) @ w2


def _rope(x, cos, sin):
    c = cos[None, :, None, None, :]
    s = sin[None, :, None, None, :]
    xf = x.astype(jnp.float32)
    x1, x2 = jnp.split(xf, 2, axis=-1)
    out = jnp.concatenate([x1 * c - x2 * s, x2 * c + x1 * s], axis=-1)
    return out.astype(x.dtype)


def _chunked_sgu(u, v, g, b, w_s, b_s):
    bsz, seq, _ = v.shape
    v = _layernorm(v, g, b)
    n_chunks = seq // CHUNK
    vb = v.reshape(bsz, n_chunks, CHUNK, N_SGU_GROUPS, SGU_GROUP)
    causal = jnp.tril(jnp.ones((CHUNK, CHUNK), dtype=bool))
    w = jnp.where(causal[None], w_s, jnp.zeros((), w_s.dtype))
    s = jnp.einsum('gtr,bnrgc->bntgc', w, vb) + b_s.T[None, None, :, :, None]
    return u * s.reshape(bsz, seq, SGU_WIDTH).astype(u.dtype)


def _diff_attention(q, k, v, lam):
    bsz, seq = q.shape[:2]
    n_blocks = seq // Q_BLOCK
    qb = q.reshape(bsz, n_blocks, Q_BLOCK, N_DIFF_HEADS, 2, DIFF_HEAD_DIM).swapaxes(0, 1)
    k_pos = jnp.arange(seq)
    scale = DIFF_HEAD_DIM ** -0.5
    neg = jnp.finfo(jnp.float32).min

    def one_block(args):
        q_blk, i = args
        s = jnp.einsum('bqhmd,bkhmd->bhmqk', q_blk, k).astype(jnp.float32) * scale
        q_pos = i * Q_BLOCK + jnp.arange(Q_BLOCK)
        mask = k_pos[None, :] <= q_pos[:, None]
        s = jnp.where(mask, s, neg)
        p = jax.nn.softmax(s, axis=-1)
        a = p[:, :, 0] - lam * p[:, :, 1]
        return jnp.einsum('bhqk,bkhe->bqhe', a.astype(v.dtype), v)

    out = lax.map(one_block, (qb, jnp.arange(n_blocks)))
    return out.swapaxes(0, 1).reshape(bsz, seq, N_DIFF_HEADS, 2 * DIFF_HEAD_DIM)


def _mixer(x, layer, w_in, gate_b, sgu_ln_g, sgu_ln_b, sgu_w, sgu_b, lam, diff_ln_g,
           w_branch, w_out, cos, sin):
    bsz, seq, _ = x.shape
    z = x @ w_in
    u, v, q, k, val, gates = jnp.split(z, SPLITS, axis=-1)
    u = jax.nn.gelu(u, approximate=False)
    v = jax.nn.gelu(v, approximate=False)
    h_a = _chunked_sgu(u, v, sgu_ln_g, sgu_ln_b, sgu_w, sgu_b)
    q = _rope(q.reshape(bsz, seq, N_DIFF_HEADS, 2, DIFF_HEAD_DIM), cos, sin)
    k = _rope(k.reshape(bsz, seq, N_DIFF_HEADS, 2, DIFF_HEAD_DIM), cos, sin)
    val = val.reshape(bsz, seq, N_DIFF_HEADS, 2 * DIFF_HEAD_DIM)
    lam_init = _lambda_init(layer)
    lf = lam.astype(jnp.float32)
    lam_full = (jnp.exp(jnp.sum(lf[0] * lf[1])) - jnp.exp(jnp.sum(lf[2] * lf[3]))
                + lam_init)
    o = _diff_attention(q, k, val, lam_full)
    o = _rmsnorm(o, diff_ln_g) * (1.0 - lam_init)
    h_b = o.reshape(bsz, seq, DIFF_V_WIDTH)
    g = jax.nn.sigmoid(gates.reshape(bsz, seq, N_BRANCH, D_MODEL) + gate_b)
    m = g[:, :, 0] * (h_a @ w_branch[0]) + g[:, :, 1] * (h_b @ w_branch[1])
    return m @ w_out


def setup_inputs(seed: int = 0) -> dict:
    key = jax.random.key(seed)
    ks = jax.random.split(key, 20)
    f32 = jnp.float32
    nrm = lambda k, shape, s: jax.random.normal(k, shape, f32) * s
    x = jax.random.normal(ks[0], (BATCH, SEQ, D_MODEL), f32)
    w_in = nrm(ks[1], (DEPTH, D_MODEL, IN_WIDTH), D_MODEL ** -0.5)
    gate_b = nrm(ks[2], (DEPTH, N_BRANCH, D_MODEL), 0.02)
    sgu_ln_g = 1.0 + nrm(ks[3], (DEPTH, SGU_WIDTH), 0.02)
    sgu_ln_b = nrm(ks[4], (DEPTH, SGU_WIDTH), 0.02)
    sgu_w = nrm(ks[5], (DEPTH, N_SGU_GROUPS, CHUNK, CHUNK), CHUNK ** -0.5)
    sgu_b = 1.0 + nrm(ks[6], (DEPTH, N_SGU_GROUPS, CHUNK), 0.02)
    lam = nrm(ks[7], (DEPTH, 4, DIFF_HEAD_DIM), 0.1)
    diff_ln_g = 1.0 + nrm(ks[8], (DEPTH, 2 * DIFF_HEAD_DIM), 0.02)
    w_branch = jnp.concatenate([
        nrm(ks[9], (DEPTH, 1, SGU_WIDTH, D_MODEL), BETA * SGU_WIDTH ** -0.5),
        nrm(ks[10], (DEPTH, 1, DIFF_V_WIDTH, D_MODEL), BETA * DIFF_V_WIDTH ** -0.5)], axis=1)
    w_out = nrm(ks[11], (DEPTH, D_MODEL, D_MODEL), BETA * D_MODEL ** -0.5)
    ffn_w1 = nrm(ks[12], (DEPTH, 2, D_MODEL, D_FF), D_MODEL ** -0.5)
    ffn_w3 = nrm(ks[13], (DEPTH, 2, D_MODEL, D_FF), D_MODEL ** -0.5)
    ffn_w2 = nrm(ks[14], (DEPTH, 2, D_FF, D_MODEL), BETA * D_FF ** -0.5)
    ln_g = 1.0 + nrm(ks[15], (DEPTH, 3, D_MODEL), 0.02)
    ln_b = nrm(ks[16], (DEPTH, 3, D_MODEL), 0.02)
    return {"x": x, "w_in": w_in, "gate_b": gate_b, "sgu_ln_g": sgu_ln_g,
            "sgu_ln_b": sgu_ln_b, "sgu_w": sgu_w, "sgu_b": sgu_b, "lam": lam,
            "diff_ln_g": diff_ln_g, "w_branch": w_branch, "w_out": w_out,
            "ffn_w1": ffn_w1, "ffn_w3": ffn_w3, "ffn_w2": ffn_w2,
            "ln_g": ln_g, "ln_b": ln_b}


def reference(x, w_in, gate_b, sgu_ln_g, sgu_ln_b, sgu_w, sgu_b, lam, diff_ln_g,
              w_branch, w_out, ffn_w1, ffn_w3, ffn_w2, ln_g, ln_b):
    seq = x.shape[1]
    pos = jnp.arange(seq, dtype=jnp.float32)
    inv_freq = ROPE_THETA ** (-jnp.arange(0, DIFF_HEAD_DIM, 2, dtype=jnp.float32) / DIFF_HEAD_DIM)
    ang = pos[:, None] * inv_freq[None, :]
    cos, sin = jnp.cos(ang), jnp.sin(ang)
    for l in range(DEPTH):
        h = _swiglu(x, ffn_w1[l, 0], ffn_w3[l, 0], ffn_w2[l, 0])
        x = _layernorm(ALPHA * x + 0.5 * h, ln_g[l, 0], ln_b[l, 0])
        h = _mixer(x, l, w_in[l], gate_b[l], sgu_ln_g[l], sgu_ln_b[l], sgu_w[l], sgu_b[l],
                   lam[l], diff_ln_g[l], w_branch[l], w_out[l], cos, sin)
        x = _layernorm(ALPHA * x + h, ln_g[l, 1], ln_b[l, 1])
        h = _swiglu(x, ffn_w1[l, 1], ffn_w3[l, 1], ffn_w2[l, 1])
        x = _layernorm(ALPHA * x + 0.5 * h, ln_g[l, 2], ln_b[l, 2])
    return x
```

```cpp
#include <hip/hip_runtime.h>
#include <hip/hip_cooperative_groups.h>
#include <cstdio>
#include <cstdint>
#include <cmath>
namespace cg = cooperative_groups;

#ifndef MK_COOP
#define MK_COOP 1
#endif

#define LAS __attribute__((address_space(3)))
typedef unsigned short bf16_t;
typedef short bf16x8 __attribute__((ext_vector_type(8)));
typedef short s16x4 __attribute__((ext_vector_type(4)));
typedef float f32x2 __attribute__((ext_vector_type(2)));
typedef float f32x4 __attribute__((ext_vector_type(4)));
typedef float f32x16 __attribute__((ext_vector_type(16)));
typedef unsigned u32x2 __attribute__((ext_vector_type(2)));
typedef unsigned u32x4 __attribute__((ext_vector_type(4)));

constexpr int SEQ = 16384, NB = 2, T = NB * SEQ, D = 1024, FF = 2816, INW = 7168, DEPTH = 4;
constexpr float LN_EPS = 1e-5f;
constexpr float ALPHA = 1.681792830507429f;
constexpr float C2 = 0.125f * 1.4426950408889634f;
constexpr int NPH = 1 + 11 * DEPTH;

constexpr size_t MiB = 1u << 20;
constexpr size_t WS_STATS = 64 * 1024;
constexpr size_t WS_ROPE = 1 * MiB;
constexpr size_t WS_SGUW = 5 * MiB;
constexpr size_t WS_XB = 8 * MiB;
constexpr size_t WS_WIN = 72 * MiB, WS_WBR = 86 * MiB, WS_WOUT = 90 * MiB;
constexpr size_t WS_BIG = 92 * MiB;
constexpr size_t WS_HCAT = WS_BIG;
constexpr size_t WS_V = WS_BIG + 128 * MiB;
constexpr size_t WS_K = WS_BIG + 192 * MiB;
constexpr size_t WS_VAL = WS_BIG + 256 * MiB;
constexpr size_t WS_GA = WS_BIG + 320 * MiB;
constexpr size_t WS_GB = WS_BIG + 384 * MiB;
constexpr size_t WS_ACT = WS_BIG;
constexpr size_t WS_WUP = WS_BIG + 320 * MiB;
constexpr size_t WS_W2 = WS_BIG + 332 * MiB;
constexpr size_t WS_END = WS_BIG + 448 * MiB;

typedef __bf16 bf16x2_t __attribute__((ext_vector_type(2)));
__device__ __forceinline__ unsigned cvt_pk_bf16(float lo, float hi) { f32x2 v = {lo, hi}; bf16x2_t b = __builtin_convertvector(v, bf16x2_t); return __builtin_bit_cast(unsigned, b); }
__device__ __forceinline__ unsigned cvtpk_s(float lo, float hi) { return cvt_pk_bf16(lo, hi); }
__device__ __forceinline__ float bf_lo(unsigned w) { return __uint_as_float(w << 16); }
__device__ __forceinline__ float bf_hi(unsigned w) { return __uint_as_float(w & 0xffff0000u); }
__device__ __forceinline__ float wave_sum(float v) {
#pragma unroll
    for (int o = 1; o < 64; o <<= 1) v += __shfl_xor(v, o);
    return v;
}
__device__ __forceinline__ f32x2 gelu_pk(f32x2 v) {
    const f32x2 av = __builtin_elementwise_abs(v), d = av * 0.2316418882f + 1.0f;
    f32x2 t; t.x = __builtin_amdgcn_rcpf(d.x); t.y = __builtin_amdgcn_rcpf(d.y);
    f32x2 q = t * 0.5307027145f + (-0.7265760135f); q = q * t + 0.7107068705f; q = q * t + (-0.142248368f); q = q * t + 0.127414796f; q = q * t;
    const f32x2 s = (v * v) * (-0.72134752044f);
    f32x2 e; e.x = __builtin_amdgcn_exp2f(s.x); e.y = __builtin_amdgcn_exp2f(s.y);
    const f32x2 m = v * (q * e), r = v - m;
    f32x2 o; o.x = v.x < 0.f ? m.x : r.x; o.y = v.y < 0.f ? m.y : r.y; return o;
}
__device__ __forceinline__ float sigmoidf_(float x) { return __builtin_amdgcn_rcpf(1.0f + __builtin_amdgcn_exp2f(-1.4426950408889634f * x)); }

namespace pg8 {
constexpr int BM = 256, BK = 64, HALF = 128, HTB = HALF * BK * 2, STAGE_BYTES = 8 * HTB, NXCD = 8, WGM = 4;
__host__ __device__ __forceinline__ int lds_byte(int r, int c) { const int st = (r >> 4) * 2 + (c >> 5), rr = r & 15, cc = c & 31, ob = rr * 64 + cc * 2; return st * 1024 + (ob ^ (((ob >> 9) & 1) << 5)); }
__host__ __device__ __forceinline__ void stage_rc(int b, int& R, int& C) { const int st = b / 1024, sb = b % 1024, swz = sb ^ (((sb >> 9) & 1) << 5); R = (st >> 1) * 16 + swz / 64; C = (st & 1) * 32 + (swz % 64) / 2; }
__host__ __device__ __forceinline__ int perm32(int rho) { const int n = rho >> 4, i = rho & 15; return 8 * (i >> 2) + 4 * n + (i & 3); }
struct Unit { int pm, pn; };
struct Gemm { const bf16_t* A; const bf16_t* Bt; int M, N, K; };
struct StaticOrder {
    int nM, nN, nwg, G, c;
    __host__ __device__ void init(int M, int N, int G_, int c_) { nM = M / BM; nN = N / BM; nwg = nM * nN; G = G_; c = c_; }
    __host__ __device__ bool next(int i, Unit& u) const {
        const long L = (long)i * G + c; if (L >= nwg) return false;
        int wgid = (int)L; { const int q = nwg / NXCD, r = nwg % NXCD, xcd = wgid % NXCD, off = wgid / NXCD; wgid = (xcd < r ? xcd * (q + 1) : r * (q + 1) + (xcd - r) * q) + off; }
        const int nig = WGM * nN, gid = wgid / nig, fm = gid * WGM, gsz = (nM - fm) < WGM ? (nM - fm) : WGM;
        u.pm = fm + ((wgid % nig) % gsz); u.pn = (wgid % nig) / gsz; return true;
    }
};
typedef f32x4 Acc[2][2][4][2];

template <class Epi, bool SP2 = true, bool ALIGN_EPI = true>
__device__ __forceinline__ void gemm_phase(LAS unsigned char* lds, const Gemm g, const StaticOrder& S, const Epi& E, const int tid) {
    const int wid = __builtin_amdgcn_readfirstlane(tid >> 6), lane = tid & 63, wr = wid >> 2, wc = wid & 3, fr = lane & 15, fq = lane >> 4;
    const int K = g.K, nt = K / BK;
    unsigned voffA[2], voffB[2];
#pragma unroll
    for (int i = 0; i < 2; ++i) { int R, C; stage_rc(tid * 16 + i * 8192, R, C); const int Rb = Epi::PERM ? ((R & ~31) + perm32(R & 31)) : R;
        voffA[i] = (unsigned)(R * K + C) * 2u; voffB[i] = (unsigned)(Rb * K + C) * 2u; }
    const size_t kstep = (size_t)(BK * 2);
    const size_t hstep = (size_t)HALF * K * 2;
    const size_t tstep = 2 * hstep;
    const unsigned ldsw = (unsigned)wid * 1024u;
    const int aoff = lds_byte(wr * 64 + fr, fq * 8), boff = lds_byte(wc * 32 + fr, fq * 8);
#define PG8_SA(b, h) (((b) * 2 + (h)) * HTB)
#define PG8_SB(b, h) ((4 + (b) * 2 + (h)) * HTB)
#define PG8_STAGE(bufoff, gbase, voff) do { _Pragma("unroll") for (int _i = 0; _i < 2; ++_i) \
        __builtin_amdgcn_global_load_lds((const unsigned*)((const char*)(gbase) + (voff)[_i]), (LAS unsigned*)(lds + (bufoff) + ldsw + _i * 8192), 16, 0, 0); } while (0)
#define PG8_LDA(dst, b, h) do { _Pragma("unroll") for (int m = 0; m < 4; ++m) _Pragma("unroll") for (int k = 0; k < 2; ++k) dst[m][k] = *(const LAS bf16x8*)(lds + PG8_SA(b, h) + aoff + m * 2048 + k * 1024); } while (0)
#define PG8_LDB(dst, b, h) do { _Pragma("unroll") for (int n = 0; n < 2; ++n) _Pragma("unroll") for (int k = 0; k < 2; ++k) dst[n][k] = *(const LAS bf16x8*)(lds + PG8_SB(b, h) + boff + n * 2048 + k * 1024); } while (0)
#define PG8_MMA(ai, bj, At, Bt) do { __builtin_amdgcn_s_setprio(1); _Pragma("unroll") for (int m = 0; m < 4; ++m) _Pragma("unroll") for (int n = 0; n < 2; ++n) _Pragma("unroll") for (int k = 0; k < 2; ++k) \
        acc[ai][bj][m][n] = __builtin_amdgcn_mfma_f32_16x16x32_bf16(Bt[n][k], At[m][k], acc[ai][bj][m][n], 0, 0, 0); __builtin_amdgcn_s_setprio(0); } while (0)
#define PG8_WAIT_V(n) asm volatile("s_waitcnt vmcnt(" #n ")" ::: "memory")
#define PG8_WAIT_L(n) asm volatile("s_waitcnt lgkmcnt(" #n ")" ::: "memory")
#define PG8_BAR __builtin_amdgcn_s_barrier()
#define PG8_SCHED __builtin_amdgcn_sched_barrier(0)
    Unit cur, nxt; int ui = 0;
    if (!S.next(0, cur)) return;
    Acc acc;
#pragma unroll
    for (int a = 0; a < 2; ++a)
#pragma unroll
        for (int b = 0; b < 2; ++b)
#pragma unroll
            for (int m = 0; m < 4; ++m)
#pragma unroll
                for (int n = 0; n < 2; ++n) acc[a][b][m][n] = (f32x4){0.f, 0.f, 0.f, 0.f};
    bf16x8 At[4][2], B0[2][2], B1[2][2];
    const char* cA = (const char*)g.A + (size_t)cur.pm * tstep; const char* cB = (const char*)g.Bt + (size_t)cur.pn * tstep;
    if constexpr (SP2) {
        PG8_STAGE(PG8_SB(0, 0), cB, voffB); PG8_STAGE(PG8_SB(0, 1), cB + hstep, voffB); PG8_STAGE(PG8_SA(0, 0), cA, voffA); PG8_STAGE(PG8_SA(0, 1), cA + hstep, voffA);
        if (wr == 1) PG8_BAR;
        PG8_WAIT_V(2); PG8_BAR;
        PG8_STAGE(PG8_SB(1, 0), cB + kstep, voffB); PG8_STAGE(PG8_SA(1, 0), cA + kstep, voffA); PG8_STAGE(PG8_SB(1, 1), cB + hstep + kstep, voffB);
        PG8_WAIT_V(6); PG8_BAR;
    } else {
        PG8_STAGE(PG8_SB(0, 0), cB, voffB); PG8_STAGE(PG8_SA(0, 0), cA, voffA); PG8_STAGE(PG8_SB(0, 1), cB + hstep, voffB); PG8_STAGE(PG8_SA(0, 1), cA + hstep, voffA);
        if (wr == 1) PG8_BAR;
        PG8_WAIT_V(4); PG8_BAR;
        PG8_STAGE(PG8_SB(1, 0), cB + kstep, voffB); PG8_STAGE(PG8_SA(1, 0), cA + kstep, voffA); PG8_STAGE(PG8_SB(1, 1), cB + hstep + kstep, voffB);
        PG8_WAIT_V(6); PG8_BAR;
    }
    for (;;) {
        const bool has_next = S.next(ui + 1, nxt);
        const char* nA = has_next ? (const char*)g.A + (size_t)nxt.pm * tstep : cA; const char* nB = has_next ? (const char*)g.Bt + (size_t)nxt.pn * tstep : cB;
        constexpr int NHALF = Epi::HOOK ? 2 : 1; const int tper = nt / NHALF;
        for (int hh = 0; hh < NHALF; ++hh) {
        if constexpr (Epi::HOOK) { if (hh == 1) { int fr_e = fr, fq_e = fq; asm volatile("" : "+v"(fr_e), "+v"(fq_e)); E.mid(acc, cur, wr, wc, fr_e, fq_e); } }
        for (int t = hh * tper; t < (hh + 1) * tper; t += 2) {
            const bool last = (t == nt - 2);
            const char* a1 = cA + (size_t)(t + 1) * kstep;
            const char* a2 = last ? nA : cA + (size_t)(t + 2) * kstep; const char* b2 = last ? nB : cB + (size_t)(t + 2) * kstep;
            const char* a3 = a2 + kstep; const char* b3 = b2 + kstep;
            if constexpr (SP2) {
            PG8_LDB(B0, 0, 0); PG8_LDB(B1, 0, 1); PG8_SCHED; PG8_LDA(At, 0, 0); PG8_STAGE(PG8_SA(1, 1), a1 + hstep, voffA);
            PG8_WAIT_V(8); PG8_WAIT_L(0); PG8_BAR; PG8_MMA(0, 0, At, B0); PG8_MMA(0, 1, At, B1); PG8_BAR; PG8_SCHED;
            PG8_LDA(At, 0, 1); PG8_STAGE(PG8_SB(0, 0), b2, voffB); PG8_STAGE(PG8_SB(0, 1), b2 + hstep, voffB); PG8_STAGE(PG8_SA(0, 0), a2, voffA);
            PG8_WAIT_V(8); PG8_WAIT_L(0); PG8_BAR; PG8_MMA(1, 0, At, B0); PG8_MMA(1, 1, At, B1); PG8_BAR; PG8_SCHED;
            PG8_LDB(B0, 1, 0); PG8_LDB(B1, 1, 1); PG8_SCHED; PG8_LDA(At, 1, 0); PG8_STAGE(PG8_SA(0, 1), a2 + hstep, voffA);
            PG8_WAIT_V(8); PG8_WAIT_L(0); PG8_BAR; PG8_MMA(0, 0, At, B0); PG8_MMA(0, 1, At, B1); PG8_BAR; PG8_SCHED;
            PG8_LDA(At, 1, 1); PG8_STAGE(PG8_SB(1, 0), b3, voffB); PG8_STAGE(PG8_SB(1, 1), b3 + hstep, voffB); PG8_STAGE(PG8_SA(1, 0), a3, voffA);
            PG8_WAIT_V(8); PG8_WAIT_L(0); PG8_BAR; PG8_MMA(1, 0, At, B0); PG8_MMA(1, 1, At, B1); PG8_BAR; PG8_SCHED;
            } else {
            PG8_LDB(B0, 0, 0); PG8_SCHED; PG8_LDA(At, 0, 0); PG8_STAGE(PG8_SA(1, 1), a1 + hstep, voffA);
            PG8_WAIT_L(8); PG8_BAR; PG8_WAIT_L(0); PG8_MMA(0, 0, At, B0); PG8_BAR; PG8_SCHED;
            PG8_LDB(B1, 0, 1); PG8_STAGE(PG8_SB(0, 0), b2, voffB);
            PG8_BAR; PG8_WAIT_L(0); PG8_MMA(0, 1, At, B1); PG8_BAR;
            PG8_LDA(At, 0, 1); PG8_STAGE(PG8_SA(0, 0), a2, voffA);
            PG8_BAR; PG8_WAIT_L(0); PG8_MMA(1, 0, At, B0); PG8_BAR; PG8_SCHED;
            PG8_STAGE(PG8_SB(0, 1), b2 + hstep, voffB);
            PG8_WAIT_V(6); PG8_BAR; PG8_MMA(1, 1, At, B1); PG8_BAR;
            PG8_LDB(B0, 1, 0); PG8_SCHED; PG8_LDA(At, 1, 0); PG8_STAGE(PG8_SA(0, 1), a2 + hstep, voffA);
            PG8_WAIT_L(8); PG8_BAR; PG8_WAIT_L(0); PG8_MMA(0, 0, At, B0); PG8_BAR; PG8_SCHED;
            PG8_LDB(B1, 1, 1); PG8_STAGE(PG8_SB(1, 0), b3, voffB);
            PG8_BAR; PG8_WAIT_L(0); PG8_MMA(0, 1, At, B1); PG8_BAR;
            PG8_LDA(At, 1, 1); PG8_STAGE(PG8_SA(1, 0), a3, voffA);
            PG8_BAR; PG8_WAIT_L(0); PG8_MMA(1, 0, At, B0); PG8_BAR; PG8_SCHED;
            PG8_STAGE(PG8_SB(1, 1), b3 + hstep, voffB);
            PG8_WAIT_V(6); PG8_BAR; PG8_MMA(1, 1, At, B1); PG8_BAR;
            }
        }
        }
        if constexpr (ALIGN_EPI) { if (wr == 0) PG8_BAR; }
        { int fr_e = fr, fq_e = fq; asm volatile("" : "+v"(fr_e), "+v"(fq_e)); E(acc, cur, wr, wc, fr_e, fq_e); }
        if (!has_next) break;
#pragma unroll
        for (int a = 0; a < 2; ++a)
#pragma unroll
            for (int b = 0; b < 2; ++b)
#pragma unroll
                for (int m = 0; m < 4; ++m)
#pragma unroll
                    for (int n = 0; n < 2; ++n) acc[a][b][m][n] = (f32x4){0.f, 0.f, 0.f, 0.f};
        cur = nxt; cA = nA; cB = nB; ++ui;
        if constexpr (ALIGN_EPI) { if (wr == 1) PG8_BAR; }
    }
    PG8_WAIT_V(0);
    if constexpr (!ALIGN_EPI) { if (wr == 0) PG8_BAR; }
    PG8_BAR;
#undef PG8_SA
#undef PG8_SB
#undef PG8_STAGE
#undef PG8_LDA
#undef PG8_LDB
#undef PG8_MMA
#undef PG8_WAIT_V
#undef PG8_WAIT_L
#undef PG8_BAR
#undef PG8_SCHED
}

struct EpiSwiGLU {
    static constexpr bool PERM = true, HOOK = false;
    bf16_t* O;
    __device__ __forceinline__ void mid(Acc&, const Unit&, int, int, int, int) const {}
    __device__ __forceinline__ void operator()(const Acc& acc, const Unit& u, int wr, int wc, int fr, int fq) const {
        const int row0 = u.pm * BM + wr * 64 + fr, col0 = u.pn * 128 + wc * 32 + 8 * fq;
#pragma unroll
        for (int ai = 0; ai < 2; ++ai)
#pragma unroll
            for (int m = 0; m < 4; ++m) {
                float r[8];
#pragma unroll
                for (int n = 0; n < 2; ++n)
#pragma unroll
                    for (int i = 0; i < 4; ++i) { const float a = acc[ai][0][m][n][i], b = acc[ai][1][m][n][i]; r[4 * n + i] = a * b * sigmoidf_(a); }
                u32x4 w; w.x = cvt_pk_bf16(r[0], r[1]); w.y = cvt_pk_bf16(r[2], r[3]); w.z = cvt_pk_bf16(r[4], r[5]); w.w = cvt_pk_bf16(r[6], r[7]);
                *(u32x4*)(O + (size_t)(row0 + ai * HALF + m * 16) * FF + col0) = w;
            }
    }
};
struct EpiResid {
    static constexpr bool PERM = false, HOOK = false;
    const float* base; float* out; float scale; const f32x2* st; const float* g; const float* b;
    __device__ __forceinline__ void mid(Acc&, const Unit&, int, int, int, int) const {}
    __device__ __forceinline__ void operator()(const Acc& acc, const Unit& u, int wr, int wc, int fr, int fq) const {
        const int row0 = u.pm * BM + wr * 64 + fr, col0 = u.pn * BM + wc * 32 + 4 * fq;
#pragma unroll
        for (int ai = 0; ai < 2; ++ai)
#pragma unroll
            for (int mh = 0; mh < 2; ++mh) {
                f32x4 pre[2][2][2]; f32x2 sv[2];
#pragma unroll
                for (int mm = 0; mm < 2; ++mm) { const int row = row0 + ai * HALF + (2 * mh + mm) * 16; const size_t off = (size_t)row * D + col0;
                    sv[mm] = st ? st[row] : (f32x2){0.f, 1.f};
#pragma unroll
                    for (int bj = 0; bj < 2; ++bj)
#pragma unroll
                        for (int n = 0; n < 2; ++n) pre[mm][bj][n] = *(const f32x4*)(base + off + bj * HALF + n * 16); }
                asm volatile("" ::: "memory");
#pragma unroll
                for (int bj = 0; bj < 2; ++bj)
#pragma unroll
                    for (int n = 0; n < 2; ++n) { f32x4 gv = (f32x4){ALPHA, ALPHA, ALPHA, ALPHA}, bv = (f32x4){0.f, 0.f, 0.f, 0.f};
                        if (st) { gv = *(const f32x4*)(g + col0 + bj * HALF + n * 16) * ALPHA; bv = *(const f32x4*)(b + col0 + bj * HALF + n * 16) * ALPHA; }
#pragma unroll
                        for (int mm = 0; mm < 2; ++mm) { const int m = 2 * mh + mm; const size_t off = (size_t)(row0 + ai * HALF + m * 16) * D + col0;
                            *(f32x4*)(out + off + bj * HALF + n * 16) = ((pre[mm][bj][n] - sv[mm].x) * sv[mm].y) * gv + bv + acc[ai][bj][m][n] * scale; } }
                asm volatile("" ::: "memory");
            }
    }
};
struct EpiMerge {
    static constexpr bool PERM = true, HOOK = true;
    const bf16_t* GA; const bf16_t* GB; bf16_t* O;
    __device__ __forceinline__ void mid(Acc& acc, const Unit& u, int wr, int wc, int fr, int fq) const {
        int row0 = u.pm * BM + wr * 64 + fr; const int col0 = u.pn * BM + wc * 32 + 8 * fq; asm volatile("" : "+v"(row0));
#pragma unroll
        for (int ai = 0; ai < 2; ++ai) {
            u32x4 ga[4][2], gb[4][2];
#pragma unroll
            for (int m = 0; m < 4; ++m)
#pragma unroll
                for (int bj = 0; bj < 2; ++bj) { const size_t off = (size_t)(row0 + ai * HALF + m * 16) * D + col0 + bj * HALF; ga[m][bj] = *(const u32x4*)(GA + off); gb[m][bj] = *(const u32x4*)(GB + off); }
            asm volatile("" ::: "memory");
#pragma unroll
            for (int m = 0; m < 4; ++m)
#pragma unroll
                for (int bj = 0; bj < 2; ++bj) {
#pragma unroll
                    for (int k = 0; k < 4; ++k) { const float rl = bf_lo(ga[m][bj][k]) * __builtin_amdgcn_rcpf(bf_lo(gb[m][bj][k])), rh = bf_hi(ga[m][bj][k]) * __builtin_amdgcn_rcpf(bf_hi(gb[m][bj][k]));
                        acc[ai][bj][m][k >> 1][(k & 1) * 2] *= rl; acc[ai][bj][m][k >> 1][(k & 1) * 2 + 1] *= rh; } }
            asm volatile("" ::: "memory");
        }
    }
    __device__ __forceinline__ void operator()(const Acc& acc, const Unit& u, int wr, int wc, int fr, int fq) const {
        const int row0 = u.pm * BM + wr * 64 + fr, col0 = u.pn * BM + wc * 32 + 8 * fq;
#pragma unroll
        for (int ai = 0; ai < 2; ++ai) {
            u32x4 gb[4][2];
#pragma unroll
            for (int m = 0; m < 4; ++m)
#pragma unroll
                for (int bj = 0; bj < 2; ++bj) gb[m][bj] = *(const u32x4*)(GB + (size_t)(row0 + ai * HALF + m * 16) * D + col0 + bj * HALF);
            asm volatile("" ::: "memory");
#pragma unroll
            for (int m = 0; m < 4; ++m)
#pragma unroll
                for (int bj = 0; bj < 2; ++bj) { u32x4 w;
#pragma unroll
                    for (int k = 0; k < 4; ++k) w[k] = cvt_pk_bf16(acc[ai][bj][m][k >> 1][(k & 1) * 2] * bf_lo(gb[m][bj][k]), acc[ai][bj][m][k >> 1][(k & 1) * 2 + 1] * bf_hi(gb[m][bj][k]));
                    *(u32x4*)(O + (size_t)(row0 + ai * HALF + m * 16) * D + col0 + bj * HALF) = w; }
            asm volatile("" ::: "memory");
        }
    }
};
struct EpiInProj {
    static constexpr bool PERM = true, HOOK = false;
    bf16_t* HCAT; bf16_t* VB; bf16_t* KB; bf16_t* VALB; bf16_t* GA; bf16_t* GB; const float* gate_b; const float* rope;
    __device__ __forceinline__ void mid(Acc&, const Unit&, int, int, int, int) const {}
    __device__ __forceinline__ void operator()(const Acc& acc, const Unit& u, int wr, int wc, int fr, int fq) const {
        const int row0 = u.pm * BM + wr * 64 + fr; const int sec = u.pn >> 2, tl = u.pn & 3;
        if (sec == 2 || sec == 3) {
            bf16_t* dst = (sec == 2) ? (HCAT + 1024) : KB; const int pitch = (sec == 2) ? 2048 : 1024; const float sc = (sec == 2) ? C2 : 1.0f;
            const int col0 = tl * 256 + wc * 64 + 8 * fq;
#pragma unroll
            for (int ai = 0; ai < 2; ++ai)
#pragma unroll
                for (int m = 0; m < 4; ++m) { const int row = row0 + ai * HALF + m * 16; const float* cs = rope + (size_t)(row & (SEQ - 1)) * 64 + 8 * fq;
                    u32x4 w1, w2;
#pragma unroll
                    for (int n = 0; n < 2; ++n) { const f32x4 c = *(const f32x4*)(cs + 4 * n) * sc, s = *(const f32x4*)(cs + 32 + 4 * n) * sc;
                        const f32x4 x1 = acc[ai][0][m][n], x2 = acc[ai][1][m][n]; const f32x4 o1 = x1 * c - x2 * s, o2 = x2 * c + x1 * s;
                        w1[2 * n] = cvt_pk_bf16(o1[0], o1[1]); w1[2 * n + 1] = cvt_pk_bf16(o1[2], o1[3]); w2[2 * n] = cvt_pk_bf16(o2[0], o2[1]); w2[2 * n + 1] = cvt_pk_bf16(o2[2], o2[3]); }
                    bf16_t* p = (sec == 2) ? dst + (size_t)row * pitch + col0
                                           : dst + ((size_t)(((row >> 14) * 8 + tl * 2 + (wc >> 1)) * SEQ + (row & (SEQ - 1)))) * 128 + (wc & 1) * 64 + 8 * fq;
                    *(u32x4*)p = w1; *(u32x4*)(p + 32) = w2; asm volatile("" ::: "memory"); }
            return;
        }
        bf16_t* dst; int pitch; int mode;
        if (sec == 0) { dst = HCAT; pitch = 2048; mode = 1; } else if (sec == 1) { dst = VB; pitch = 1024; mode = 1; } else if (sec == 4) { dst = VALB; pitch = 1024; mode = 0; }
        else if (sec == 5) { dst = GA; pitch = 1024; mode = 2; } else { dst = GB; pitch = 1024; mode = 2; }
        const int col0 = tl * 256 + wc * 32 + 8 * fq;
        const float* gbp = gate_b + (mode == 2 ? (sec - 5) * 1024 + col0 : 0);
#pragma unroll
        for (int ai = 0; ai < 2; ++ai)
#pragma unroll
            for (int m = 0; m < 4; ++m) { const int row = row0 + ai * HALF + m * 16; bf16_t* rowp = dst + (size_t)row * pitch + col0;
                if (mode == 0) rowp = dst + ((size_t)(((row >> 14) * 8 + tl * 2) * SEQ + (row & (SEQ - 1)))) * 128 + wc * 32 + 8 * fq;
#pragma unroll
                for (int bj = 0; bj < 2; ++bj) { f32x4 v0 = acc[ai][bj][m][0], v1 = acc[ai][bj][m][1];
                    if (mode == 1) { f32x2 a = gelu_pk((f32x2){v0[0], v0[1]}), b = gelu_pk((f32x2){v0[2], v0[3]}), c = gelu_pk((f32x2){v1[0], v1[1]}), d = gelu_pk((f32x2){v1[2], v1[3]});
                        v0 = (f32x4){a.x, a.y, b.x, b.y}; v1 = (f32x4){c.x, c.y, d.x, d.y}; }
                    else if (mode == 2) { v0 = v0 + *(const f32x4*)(gbp + bj * HALF); v1 = v1 + *(const f32x4*)(gbp + bj * HALF + 4);
#pragma unroll
                        for (int i = 0; i < 4; ++i) { v0[i] = sigmoidf_(v0[i]); v1[i] = sigmoidf_(v1[i]); } }
                    u32x4 w; w.x = cvt_pk_bf16(v0[0], v0[1]); w.y = cvt_pk_bf16(v0[2], v0[3]); w.z = cvt_pk_bf16(v1[0], v1[1]); w.w = cvt_pk_bf16(v1[2], v1[3]);
                    *(u32x4*)(rowp + (mode == 0 ? (size_t)bj * SEQ * 128 : (size_t)bj * HALF)) = w; } }
    }
};
}

namespace att {
__device__ __forceinline__ int crow(int r, int hi) { return (r & 3) + 8 * (r >> 2) + 4 * hi; }
__device__ __forceinline__ void glds16(const void* gsrc, unsigned lds_dst) { unsigned keep;
    asm volatile("s_mov_b32 %0, m0\n\ts_mov_b32 m0, %2\n\ts_nop 0\n\tglobal_load_lds_dwordx4 %1, off\n\ts_mov_b32 m0, %0" : "=&s"(keep) : "v"(gsrc), "s"(lds_dst) : "memory"); }
typedef short v4i16_t __attribute__((ext_vector_type(4)));
__device__ __forceinline__ s16x4 vtr(LAS const unsigned char* p) { return __builtin_bit_cast(s16x4, __builtin_amdgcn_ds_read_tr16_b64_v4i16((LAS v4i16_t*)p)); }
#define ATT_MFMA(a, b, c) __builtin_amdgcn_mfma_f32_32x32x16_bf16(a, b, c, 0, 0, 0)
constexpr int STAGE = 32768;
constexpr int NSTAGE = 4;
constexpr int XOFF = 0;
constexpr int XRG = 32 * 136;
constexpr int WSOFF = NSTAGE * STAGE;

__device__ __forceinline__ float fadd_s(float a, float b) { float r = a + b; asm("" : "+v"(r)); return r; }
template <bool SLOW>
__device__ __forceinline__ void stepX(u32x4 (&pw)[4], f32x16& p1, float& l, f32x16& negm, const bf16x8 (&qr)[4], LAS const unsigned char* ka, LAS const unsigned char* kb, int kv0, int qpos, int hi, const bool first, LAS const unsigned char* vb, s16x4 (&vlo)[4], s16x4 (&vhh)[4]) {
    f32x16 p0;
    if (SLOW && first) {
#pragma unroll
        for (int r = 0; r < 16; ++r) negm[r] = 0.f;
    }
    bf16x8 kf[8];
#pragma unroll
    for (int d0 = 0; d0 < 4; ++d0) { LAS const unsigned char* kp = ((d0 & 1) ? kb : ka) + (d0 >> 1) * 512; kf[d0] = *(LAS const bf16x8*)(kp); }
#pragma unroll
    for (int d0 = 0; d0 < 4; ++d0) { LAS const unsigned char* kp = ((d0 & 1) ? kb : ka) + (d0 >> 1) * 512; kf[4 + d0] = *(LAS const bf16x8*)(kp + 4096); }
    __builtin_amdgcn_s_setprio(2);
    p0 = ATT_MFMA(kf[0], qr[0], negm);
#pragma unroll
    for (int d0 = 1; d0 < 4; ++d0) p0 = ATT_MFMA(kf[d0], qr[d0], p0);
    if (!SLOW) __builtin_amdgcn_sched_barrier(0);
    if (SLOW) {
        p1 = ATT_MFMA(kf[4], qr[0], negm);
#pragma unroll
        for (int d0 = 1; d0 < 4; ++d0) p1 = ATT_MFMA(kf[4 + d0], qr[d0], p1);
        __builtin_amdgcn_s_setprio(0);
        __builtin_amdgcn_sched_barrier(0);
    }
    if (SLOW) {
        int dq = qpos - kv0 - 4 * hi; asm volatile("" : "+v"(dq));
#pragma unroll
        for (int r = 0; r < 16; ++r) { const int cr = (r & 3) + 8 * (r >> 2); p0[r] = (cr > dq) ? -INFINITY : p0[r]; p1[r] = (cr + 32 > dq) ? -INFINITY : p1[r]; }
    }
    if (SLOW && first) {
        float rm = fmaxf(p0[0], p1[0]);
#pragma unroll
        for (int r = 1; r < 16; ++r) rm = fmaxf(rm, fmaxf(p0[r], p1[r]));
        rm = fmaxf(rm, __shfl_xor(rm, 32));
#pragma unroll
        for (int r = 0; r < 16; ++r) { p0[r] -= rm; p1[r] -= rm; negm[r] = -rm; }
    }
    float sa = 0.f, sb = 0.f;
    if (!SLOW) {
#pragma unroll
        for (int g = 0; g < 4; ++g) {
            p1 = (g == 0) ? ATT_MFMA(kf[4], qr[0], negm) : ATT_MFMA(kf[4 + g], qr[g], p1);
#pragma unroll
            for (int r = 4 * g; r < 4 * g + 4; r += 2) { p0[r] = __builtin_amdgcn_exp2f(p0[r]); p0[r + 1] = __builtin_amdgcn_exp2f(p0[r + 1]); sa = fadd_s(sa, p0[r]); sb = fadd_s(sb, p0[r + 1]); }
            if (g & 1) { const int w = g >> 1;
#pragma unroll
                for (int k = 0; k < 4; ++k) pw[w][k] = cvtpk_s(p0[8 * w + 2 * k], p0[8 * w + 2 * k + 1]); }
            __builtin_amdgcn_sched_barrier(0);
        }
        l += sa + sb;
        __builtin_amdgcn_s_setprio(0);
    } else {
#pragma unroll
        for (int r = 0; r < 16; r += 2) { p0[r] = __builtin_amdgcn_exp2f(p0[r]); p0[r + 1] = __builtin_amdgcn_exp2f(p0[r + 1]); sa = fadd_s(sa, p0[r]); sb = fadd_s(sb, p0[r + 1]); }
        l += sa + sb;
#pragma unroll
        for (int k = 0; k < 4; ++k) { pw[0][k] = cvtpk_s(p0[2 * k], p0[2 * k + 1]); pw[1][k] = cvtpk_s(p0[8 + 2 * k], p0[8 + 2 * k + 1]); }
    }
#pragma unroll
    for (int j = 0; j < 4; ++j) { vlo[j] = vtr(vb + j * 4096); vhh[j] = vtr(vb + j * 4096 + 512); }
}
__device__ __forceinline__ void stepY(f32x16 (&o)[4], u32x4 (&pw)[4], f32x16& p1, float& l, LAS const unsigned char* vb, const s16x4 (&vlo)[4], const s16x4 (&vhh)[4]) {
    __builtin_amdgcn_sched_barrier(0);
    s16x4 lo[16], hh[16];
#define ATT_VRD(j) do { lo[j] = vtr(vb + ((j) & 3) * 4096 + ((j) >> 2) * 1024); hh[j] = vtr(vb + ((j) & 3) * 4096 + ((j) >> 2) * 1024 + 512); } while (0)
#pragma unroll
    for (int j = 0; j < 4; ++j) { lo[j] = vlo[j]; hh[j] = vhh[j]; }
    float sa = 0.f, sb = 0.f;
#pragma unroll
    for (int j = 0; j < 16; ++j) {
        if (j + 4 < 16) ATT_VRD(j + 4);
        { const bf16x8 vf = (bf16x8){lo[j][0], lo[j][1], lo[j][2], lo[j][3], hh[j][0], hh[j][1], hh[j][2], hh[j][3]};
          o[j & 3] = ATT_MFMA(__builtin_bit_cast(bf16x8, pw[j >> 2]), vf, o[j & 3]); }
        if (j < 8) { p1[2 * j] = __builtin_amdgcn_exp2f(p1[2 * j]); p1[2 * j + 1] = __builtin_amdgcn_exp2f(p1[2 * j + 1]); sa = fadd_s(sa, p1[2 * j]); sb = fadd_s(sb, p1[2 * j + 1]); }
        if (j == 3 || j == 7) { const int w = j >> 2;
#pragma unroll
            for (int k = 0; k < 4; ++k) pw[2 + w][k] = cvtpk_s(p1[8 * w + 2 * k], p1[8 * w + 2 * k + 1]); }
        __builtin_amdgcn_sched_barrier(0);
    }
#undef ATT_VRD
    l += sa + sb;
}

struct Params { const bf16_t* Q; const bf16_t* K; const bf16_t* V; bf16_t* O; const float* g; float lam, oscale; };

template <int GRP>
__device__ __forceinline__ void run_tiles(f32x16 (&o)[4], float& l, const bf16x8 (&qr)[4], LAS unsigned char* lds, const unsigned ldsbase, const bf16_t* ksrc, const bf16_t* vsrc, int wid, int NT, int qa, int qpos, int hi, int kA, int kB, int voff) {
#define ATT_DMA(t, sboff) do { const unsigned sb_ = ldsbase + (unsigned)(sboff); const size_t go_ = (size_t)(t) * 64 * 128; \
        glds16(ksrc + go_, (unsigned)__builtin_amdgcn_readfirstlane(sb_ + wid * 1024)); \
        glds16(ksrc + go_ + 64, (unsigned)__builtin_amdgcn_readfirstlane(sb_ + 8192 + wid * 1024)); \
        glds16(vsrc + go_, (unsigned)__builtin_amdgcn_readfirstlane(sb_ + 16384 + (wid >> 1) * 4096 + (wid & 1) * 2048)); \
        glds16(vsrc + go_ + 16 * 128, (unsigned)__builtin_amdgcn_readfirstlane(sb_ + 16384 + (wid >> 1) * 4096 + (wid & 1) * 2048 + 1024)); } while (0)
#define END_EVEN() asm volatile("s_waitcnt lgkmcnt(0)\n\ts_barrier" ::: "memory")
#define END_ODD4() asm volatile("s_waitcnt vmcnt(4) lgkmcnt(0)\n\ts_barrier" ::: "memory")
#define END_ODD8() asm volatile("s_waitcnt vmcnt(8) lgkmcnt(0)\n\ts_barrier" ::: "memory")
#define END_ODDN(nn) do { if ((nn) >= 2) END_ODD8(); else if ((nn) == 1) END_ODD4(); else END_ODD0(); } while (0)
#define END_ODD0() asm volatile("s_waitcnt vmcnt(0) lgkmcnt(0)\n\ts_barrier" ::: "memory")
#define NXT(s) (((s) == (NSTAGE - 1) * STAGE) ? 0 : (s) + STAGE)
    u32x4 pw[4]; f32x16 negm, p1k; s16x4 vlo[4], vhh[4];
#pragma unroll
    for (int j = 0; j < 4; ++j) { vlo[j] = (s16x4){0, 0, 0, 0}; vhh[j] = (s16x4){0, 0, 0, 0}; }
#pragma unroll
    for (int r = 0; r < 16; ++r) p1k[r] = 0.f;
#pragma unroll
    for (int k = 0; k < 4; ++k) pw[k] = (u32x4){0u, 0u, 0u, 0u};
#define SLOW_X(t, sc) do { const int kv0_ = 64 * (t); if (kv0_ <= qa + 31) stepX<true>(pw, p1k, l, negm, qr, lds + (sc) + kA, lds + (sc) + kB, kv0_, qpos, hi, (t) == 0, lds + (sc) + voff, vlo, vhh); } while (0)
#define SLOW_Y(t, sc) do { if (64 * (t) <= qa + 31) stepY(o, pw, p1k, l, lds + (sc) + voff, vlo, vhh); } while (0)
    int sc = 0;
    if (GRP == 1) END_EVEN();
#define TILE_SLOW(t) do { const int s3_ = (sc == 0) ? (NSTAGE - 1) * STAGE : sc - STAGE; const bool iss_ = ((t) + 3 < NT); const int newer_ = ((t) + 3 < NT ? 1 : 0) + ((t) + 2 < NT ? 1 : 0); \
        if (GRP == 0) { SLOW_X(t, sc); END_EVEN(); if (iss_) ATT_DMA((t) + 3, s3_); SLOW_Y(t, sc); END_ODDN(newer_); } \
        else          { if (iss_) ATT_DMA((t) + 3, s3_); SLOW_X(t, sc); END_ODDN(newer_); SLOW_Y(t, sc); END_EVEN(); } \
        sc = NXT(sc); } while (0)
    TILE_SLOW(0);
    int t = 1;
    for (; t < NT - 3; ++t) {
        const int s3 = (sc == 0) ? (NSTAGE - 1) * STAGE : sc - STAGE;
        if (GRP == 0) { stepX<false>(pw, p1k, l, negm, qr, lds + sc + kA, lds + sc + kB, 64 * t, qpos, hi, false, lds + sc + voff, vlo, vhh); END_EVEN(); ATT_DMA(t + 3, s3); stepY(o, pw, p1k, l, lds + sc + voff, vlo, vhh); END_ODD8(); }
        else          { ATT_DMA(t + 3, s3); stepX<false>(pw, p1k, l, negm, qr, lds + sc + kA, lds + sc + kB, 64 * t, qpos, hi, false, lds + sc + voff, vlo, vhh); END_ODD8(); stepY(o, pw, p1k, l, lds + sc + voff, vlo, vhh); END_EVEN(); }
        sc = NXT(sc);
    }
    for (; t < NT; ++t) TILE_SLOW(t);
#undef TILE_SLOW
    if (GRP == 0) END_EVEN();
#undef SLOW_X
#undef SLOW_Y
}

__device__ __forceinline__ void unit(int b, int h, int qb, const Params& P, LAS unsigned char* lds, const int tid) {
    const int lane = tid & 63, r32 = lane & 31, hi = lane >> 5; const int wid = __builtin_amdgcn_readfirstlane(tid >> 6);
    const int rg = wid >> 1, mp = wid & 1;
    const size_t rowbase = (size_t)b * SEQ; const int q0 = qb * 128, NT = 2 * qb + 2, qa = q0 + 32 * rg, qpos = qa + r32;
    const unsigned ldsbase = (unsigned)(uintptr_t)lds;
    const size_t hbase = (size_t)(b * 8 + h) * SEQ;
    const bf16_t* ksrc = P.K + (hbase + 8 * wid + (lane & 7)) * 128 + (((lane >> 3) ^ (wid & 3)) * 8);
    const bf16_t* vsrc = P.V + (hbase + 32 * (wid & 1) + (lane >> 2)) * 128 + (wid >> 1) * 32 + (lane & 3) * 8;
#define ATT_WAITBAR() asm volatile("s_waitcnt vmcnt(0) lgkmcnt(0)\n\ts_barrier" ::: "memory")
    ATT_DMA(0, 0); ATT_DMA(1, STAGE); if (NT > 2) ATT_DMA(2, 2 * STAGE);
    bf16x8 qr[4];
    { const bf16_t* Qp = P.Q + (rowbase + qpos) * 2048 + h * 128 + mp * 64 + 8 * hi;
#pragma unroll
      for (int d0 = 0; d0 < 4; ++d0) qr[d0] = *(const bf16x8*)(Qp + 16 * d0); }
    f32x16 o[4];
#pragma unroll
    for (int d = 0; d < 4; ++d)
#pragma unroll
        for (int r = 0; r < 16; ++r) o[d][r] = 0.f;
    float l = 0.f;
    LAS float* wsf = (LAS float*)(lds + WSOFF) + wid * 64;
    const int kg = r32 >> 3, kbase0 = mp * 8192 + kg * 1024 + ((hi ^ (kg & 1)) * 128) + (r32 & 7) * 16;
    const int kA = kbase0 + 256 * (kg >> 1), kB = kbase0 + 256 * (1 - (kg >> 1));
    const int voff = 16384 + ((lane >> 4) & 1) * 32 + (lane & 3) * 8 + (4 * hi + ((lane & 15) >> 2)) * 64;
    ATT_WAITBAR();
    asm volatile("" :: "v"(qr[0]), "v"(qr[1]), "v"(qr[2]), "v"(qr[3]));
    if (wid < 4) run_tiles<0>(o, l, qr, lds, ldsbase, ksrc, vsrc, wid, NT, qa, qpos, hi, kA, kB, voff);
    else         run_tiles<1>(o, l, qr, lds, ldsbase, ksrc, vsrc, wid, NT, qa, qpos, hi, kA, kB, voff);
    int hi_e = hi, r32_e = r32; asm volatile("" : "+v"(hi_e), "+v"(r32_e));
    l += __shfl_xor(l, 32);
    const float inv = 1.0f / l;
    wsf[r32_e] = inv;
    LAS const float* wsr = wsf + 4 * hi_e;
#pragma unroll
    for (int r = 0; r < 16; ++r) { const float il = wsr[crow(r, 0)];
#pragma unroll
        for (int d = 0; d < 4; ++d) o[d][r] *= il; }
    LAS float* XB = (LAS float*)(lds + XOFF) + rg * XRG;
    LAS float* X = XB + (4 * hi_e) * 136 + r32_e;
    if (mp == 1) {
#pragma unroll
        for (int r = 0; r < 16; ++r)
#pragma unroll
            for (int d = 0; d < 4; ++d) X[crow(r, 0) * 136 + (d >> 1) * 68 + (d & 1) * 32] = o[d][r];
    }
    ATT_WAITBAR();
    if (mp == 0) {
#pragma unroll
        for (int r = 0; r < 16; ++r)
#pragma unroll
            for (int d = 0; d < 4; ++d) { LAS float* xp = X + crow(r, 0) * 136 + (d >> 1) * 68 + (d & 1) * 32; *xp = o[d][r] - P.lam * (*xp); }
        asm volatile("s_waitcnt lgkmcnt(0)" ::: "memory");
        int lane_e = r32_e + 32 * hi_e; const int row = lane_e >> 1, half = lane_e & 1;
        LAS const f32x4* rp = (LAS const f32x4*)(XB + row * 136 + half * 68);
        f32x4 v4[16]; float ss = 0.f;
#pragma unroll
        for (int k = 0; k < 16; ++k) { v4[k] = rp[k]; ss += (v4[k].x * v4[k].x + v4[k].y * v4[k].y) + (v4[k].z * v4[k].z + v4[k].w * v4[k].w); }
        ss += __shfl_xor(ss, 1);
        const float rs = __builtin_amdgcn_rsqf(ss * (1.0f / 128.0f) + LN_EPS) * P.oscale;
        bf16_t* op = P.O + (rowbase + qa + row) * 2048 + h * 128 + half * 64; const float* gp = P.g + half * 64;
#pragma unroll
        for (int k = 0; k < 8; ++k) { const f32x4 g0 = *(const f32x4*)(gp + 8 * k) * rs, g1 = *(const f32x4*)(gp + 8 * k + 4) * rs; const f32x4 a0 = v4[2 * k] * g0, a1 = v4[2 * k + 1] * g1;
            u32x4 w; w.x = cvt_pk_bf16(a0.x, a0.y); w.y = cvt_pk_bf16(a0.z, a0.w); w.z = cvt_pk_bf16(a1.x, a1.y); w.w = cvt_pk_bf16(a1.z, a1.w);
            *(u32x4*)(op + 8 * k) = w; }
    }
    ATT_WAITBAR();
#undef ATT_DMA
#undef END_EVEN
#undef END_ODD4
#undef END_ODD8
#undef END_ODDN
#undef END_ODD0
#undef NXT
}
}

struct Args { const float* in[16]; float* out; unsigned char* ws; float invf[32]; float lam_init[4]; int ph_lo, ph_hi, coop, pad; };

struct Ctx { int tid, lane, wave, gw, NGW; LAS unsigned char* lds; };

struct TrItem { const float* W; bf16_t* dst; int ldw, k0, n0, pitch, drow0, dcol0; };
__device__ __forceinline__ void tr_load(const TrItem& t, float (&wv)[32], int lane) {
#pragma unroll
    for (int i = 0; i < 32; ++i) { const int kk = 2 * i + (lane >> 5); wv[i] = t.W[(size_t)(t.k0 + kk) * t.ldw + t.n0 + (lane & 31)]; }
}
__device__ __forceinline__ void tr_store(const TrItem& t, const float (&wv)[32], LAS float* scr, int lane) {
#pragma unroll
    for (int i = 0; i < 32; ++i) { const int kk = 2 * i + (lane >> 5); scr[kk * 33 + (lane & 31)] = wv[i]; }
    asm volatile("s_waitcnt lgkmcnt(0)" ::: "memory");
    const int c = lane & 7;
#pragma unroll
    for (int j = 0; j < 4; ++j) { const int n = (lane >> 3) + 8 * j; const LAS float* s = scr + (8 * c) * 33 + n;
        u32x4 o; o.x = cvt_pk_bf16(s[0 * 33], s[1 * 33]); o.y = cvt_pk_bf16(s[2 * 33], s[3 * 33]); o.z = cvt_pk_bf16(s[4 * 33], s[5 * 33]); o.w = cvt_pk_bf16(s[6 * 33], s[7 * 33]);
        *(u32x4*)(t.dst + (size_t)(t.drow0 + n) * t.pitch + t.dcol0 + 8 * c) = o; }
    asm volatile("s_waitcnt lgkmcnt(0)" ::: "memory");
}
__device__ __forceinline__ TrItem ffn_item(const Args& a, int l, int f, int it) {
    const size_t wo = (size_t)(l * 2 + f) * D * FF; TrItem t;
    if (it < 2816) { const int r = it < 1408 ? it : it - 1408; const int kb = r / 88, nb = r % 88, n0 = 32 * nb;
        t.W = (it < 1408 ? a.in[11] : a.in[12]) + wo; t.ldw = FF; t.k0 = 64 * kb; t.n0 = n0; t.dst = (bf16_t*)(a.ws + WS_WUP); t.pitch = D; t.drow0 = (n0 >> 7) * 256 + (n0 & 127) + (it < 1408 ? 0 : 128); t.dcol0 = 64 * kb; }
    else { const int r = it - 2816, kb = r >> 5, nb = r & 31; t.W = a.in[13] + wo; t.ldw = D; t.k0 = 64 * kb; t.n0 = 32 * nb; t.dst = (bf16_t*)(a.ws + WS_W2); t.pitch = FF; t.drow0 = 32 * nb; t.dcol0 = 64 * kb; }
    return t;
}
__device__ __forceinline__ TrItem mixer_item(const Args& a, int l, int it) {
    TrItem t;
    if (it < 3584) { const int kb = it / 224, nb = it % 224, n0 = 32 * nb; int dr = n0;
        if (n0 >= 2048 && n0 < 4096) { const int w = n0 & 255; dr = (n0 & ~255) + ((w >> 5) & 1) * 128 + (w >> 6) * 32; }
        t.W = a.in[1] + (size_t)l * D * INW; t.ldw = INW; t.k0 = 64 * kb; t.n0 = n0; t.dst = (bf16_t*)(a.ws + WS_WIN); t.pitch = D; t.drow0 = dr; t.dcol0 = 64 * kb; }
    else if (it < 4608) { const int r = it - 3584, br = r >> 9, q = r & 511, kb = q >> 5, nb = q & 31;
        t.W = a.in[9] + (size_t)l * 2 * D * D + (size_t)br * D * D; t.ldw = D; t.k0 = 64 * kb; t.n0 = 32 * nb; t.dst = (bf16_t*)(a.ws + WS_WBR); t.pitch = 2048; t.drow0 = 32 * nb; t.dcol0 = br * 1024 + 64 * kb; }
    else { const int q = it - 4608, kb = q >> 5, nb = q & 31; t.W = a.in[10] + (size_t)l * D * D; t.ldw = D; t.k0 = 64 * kb; t.n0 = 32 * nb; t.dst = (bf16_t*)(a.ws + WS_WOUT); t.pitch = D; t.drow0 = 32 * nb; t.dcol0 = 64 * kb; }
    return t;
}
__device__ __forceinline__ void conv_ffn(const Ctx& C, const Args& a, int l, int f) {
    LAS float* scr = (LAS float*)(C.lds + C.wave * 8448);
    int it = C.gw; if (it >= 4224) return;
    TrItem cur = ffn_item(a, l, f, it); float wv[32]; tr_load(cur, wv, C.lane);
    for (;;) {
        const int nx = it + C.NGW; const bool more = nx < 4224;
        TrItem nxt = cur; float wn[32];
        if (more) { nxt = ffn_item(a, l, f, nx); tr_load(nxt, wn, C.lane); }
        tr_store(cur, wv, scr, C.lane);
        if (!more) break;
        cur = nxt; it = nx;
#pragma unroll
        for (int i = 0; i < 32; ++i) wv[i] = wn[i];
    }
}
__device__ __forceinline__ void conv_mixer(const Ctx& C, const Args& a, int l) {
    LAS float* scr = (LAS float*)(C.lds + C.wave * 8448);
    { int it = C.gw;
      if (it < 5120) {
        TrItem cur = mixer_item(a, l, it); float wv[32]; tr_load(cur, wv, C.lane);
        for (;;) {
            const int nx = it + C.NGW; const bool more = nx < 5120;
            TrItem nxt = cur; float wn[32];
            if (more) { nxt = mixer_item(a, l, nx); tr_load(nxt, wn, C.lane); }
            tr_store(cur, wv, scr, C.lane);
            if (!more) break;
            cur = nxt; it = nx;
#pragma unroll
            for (int i = 0; i < 32; ++i) wv[i] = wn[i];
        }
      } }
    const float* sw = a.in[5] + (size_t)l * 8 * 128 * 128; bf16_t* SW = (bf16_t*)(a.ws + WS_SGUW);
    for (int i = C.gw * 64 + C.lane; i < 8 * 128 * 128 / 2; i += C.NGW * 64) { const int e = 2 * i, r = e & 127, t = (e >> 7) & 127;
        const f32x2 v = *(const f32x2*)(sw + e); *(unsigned*)(SW + e) = cvt_pk_bf16(r <= t ? v.x : 0.f, (r + 1) <= t ? v.y : 0.f); }
}
__device__ __forceinline__ void ln_rows(const Ctx& C, float* y, bf16_t* xb, const float* g, const float* b, f32x2* stats, const bool write_f32) {
    f32x4 gg[4], bb[4];
#pragma unroll
    for (int j = 0; j < 4; ++j) { gg[j] = ((const f32x4*)g)[C.lane + 64 * j]; bb[j] = ((const f32x4*)b)[C.lane + 64 * j]; }
    for (int m = C.gw; m < T; m += C.NGW) {
        f32x4* row = (f32x4*)(y + (size_t)m * D) + C.lane; f32x4 v[4]; float s = 0.f;
#pragma unroll
        for (int j = 0; j < 4; ++j) { v[j] = row[64 * j]; s += (v[j].x + v[j].y) + (v[j].z + v[j].w); }
        const float mean = wave_sum(s) * (1.f / D); float s2 = 0.f;
#pragma unroll
        for (int j = 0; j < 4; ++j) { v[j] = v[j] - mean; s2 += (v[j].x * v[j].x + v[j].y * v[j].y) + (v[j].z * v[j].z + v[j].w * v[j].w); }
        const float rstd = 1.f / sqrtf(wave_sum(s2) * (1.f / D) + LN_EPS);
        if (C.lane == 0) stats[m] = (f32x2){mean, rstd};
        u32x2* o8 = (u32x2*)(xb + (size_t)m * D) + C.lane;
#pragma unroll
        for (int j = 0; j < 4; ++j) { const f32x4 o = v[j] * rstd * gg[j] + bb[j]; if (write_f32) row[64 * j] = o; u32x2 w; w.x = cvt_pk_bf16(o.x, o.y); w.y = cvt_pk_bf16(o.z, o.w); o8[64 * j] = w; }
    }
}
__device__ __forceinline__ void prologue(const Ctx& C, const Args& a) {
    const float* x = a.in[0]; bf16_t* xb = (bf16_t*)(a.ws + WS_XB);
    for (int m0 = C.gw; m0 < T; m0 += 4 * C.NGW) {
        f32x4 v[4][4];
#pragma unroll
        for (int q = 0; q < 4; ++q) { const int m = m0 + q * C.NGW; if (m < T) { const f32x4* row = (const f32x4*)(x + (size_t)m * D) + C.lane;
#pragma unroll
            for (int j = 0; j < 4; ++j) v[q][j] = row[64 * j]; } }
#pragma unroll
        for (int q = 0; q < 4; ++q) { const int m = m0 + q * C.NGW; if (m < T) { u32x2* o8 = (u32x2*)(xb + (size_t)m * D) + C.lane;
#pragma unroll
            for (int j = 0; j < 4; ++j) { u32x2 w; w.x = cvt_pk_bf16(v[q][j].x, v[q][j].y); w.y = cvt_pk_bf16(v[q][j].z, v[q][j].w); o8[64 * j] = w; } } }
    }
    float* rope = (float*)(a.ws + WS_ROPE);
    for (int i = C.gw * 64 + C.lane; i < SEQ * 32; i += C.NGW * 64) { const int pos = i >> 5, j = i & 31;
        const float ang = __fmul_rn((float)pos, a.invf[j]); const double ad = (double)ang;
        const double n = __builtin_rint(ad * 0.15915494309189535); const double r = (ad - n * 6.283185307179586) - n * 2.4492935982947064e-16; const double r2 = r * r;
        double sn = 1.0, cs = 1.0;
#pragma unroll
        for (int k = 13; k >= 1; --k) { sn = 1.0 - r2 * (1.0 / (double)((2 * k) * (2 * k + 1))) * sn; cs = 1.0 - r2 * (1.0 / (double)((2 * k - 1) * (2 * k))) * cs; }
        sn *= r;
        rope[(size_t)pos * 64 + j] = (float)cs; rope[(size_t)pos * 64 + 32 + j] = (float)sn; }
    conv_ffn(C, a, 0, 0);
}
__device__ __forceinline__ void sgu_chunk(const Ctx& C, const Args& a, int l, int n) {
    LAS unsigned char* lds = C.lds; LAS f32x2* stats = (LAS f32x2*)lds; LAS unsigned char* vimg = lds + 1024;
    const bf16_t* VB = (const bf16_t*)(a.ws + WS_V); bf16_t* HC = (bf16_t*)(a.ws + WS_HCAT); const bf16_t* SW = (const bf16_t*)(a.ws + WS_SGUW);
    const float* gam = a.in[3] + l * D; const float* bet = a.in[4] + l * D; const float* sb = a.in[6] + l * 1024;
    const size_t R0 = (size_t)n * 128; const int lane = C.lane, wid = C.wave, r32 = lane & 31, hi = lane >> 5;
    for (int rr = 0; rr < 16; ++rr) { const int r = wid * 16 + rr; const u32x4* p = (const u32x4*)(VB + (R0 + r) * D); const u32x4 a0 = p[lane], a1 = p[64 + lane];
        float s = 0.f, s2 = 0.f;
#pragma unroll
        for (int k = 0; k < 4; ++k) { const float x0 = bf_lo(a0[k]), x1 = bf_hi(a0[k]), x2 = bf_lo(a1[k]), x3 = bf_hi(a1[k]); s += (x0 + x1) + (x2 + x3); s2 += (x0 * x0 + x1 * x1) + (x2 * x2 + x3 * x3); }
        s = wave_sum(s); s2 = wave_sum(s2); const float mean = s * (1.f / D); const float var = fmaxf(s2 * (1.f / D) - mean * mean, 0.f);
        if (lane == 0) stats[r] = (f32x2){mean, 1.f / sqrtf(var + LN_EPS)}; }
    __syncthreads();
    const int tb = wid >> 1, ch = wid & 1;
    const int voff = ((lane >> 4) & 1) * 32 + (lane & 3) * 8 + (4 * hi + ((lane & 15) >> 2)) * 64;
    for (int g = 0; g < 8; ++g) {
#pragma unroll
        for (int j = 0; j < 4; ++j) { const int p = C.tid + 512 * j, r = p >> 4, c8 = (p & 15) * 8; const f32x2 st = stats[r];
            const u32x4 w = *(const u32x4*)(VB + (R0 + r) * D + g * 128 + c8); const f32x4 g0 = *(const f32x4*)(gam + g * 128 + c8), g1 = *(const f32x4*)(gam + g * 128 + c8 + 4);
            const f32x4 b0 = *(const f32x4*)(bet + g * 128 + c8), b1 = *(const f32x4*)(bet + g * 128 + c8 + 4);
            u32x4 o; o.x = cvt_pk_bf16((bf_lo(w.x) - st.x) * st.y * g0[0] + b0[0], (bf_hi(w.x) - st.x) * st.y * g0[1] + b0[1]);
            o.y = cvt_pk_bf16((bf_lo(w.y) - st.x) * st.y * g0[2] + b0[2], (bf_hi(w.y) - st.x) * st.y * g0[3] + b0[3]);
            o.z = cvt_pk_bf16((bf_lo(w.z) - st.x) * st.y * g1[0] + b1[0], (bf_hi(w.z) - st.x) * st.y * g1[1] + b1[1]);
            o.w = cvt_pk_bf16((bf_lo(w.w) - st.x) * st.y * g1[2] + b1[2], (bf_hi(w.w) - st.x) * st.y * g1[3] + b1[3]);
            *(LAS u32x4*)(vimg + (c8 >> 5) * 8192 + r * 64 + (c8 & 31) * 2) = o; }
        __syncthreads();
        f32x16 acc[2];
#pragma unroll
        for (int r = 0; r < 16; ++r) { acc[0][r] = 0.f; acc[1][r] = 0.f; }
        const bf16_t* wrow = SW + ((size_t)g * 128 + 32 * tb + r32) * 128 + 4 * hi;
#pragma unroll
        for (int kc = 0; kc < 8; ++kc) {
            const u32x2 alo = *(const u32x2*)(wrow + 16 * kc), ahi = *(const u32x2*)(wrow + 16 * kc + 8);
            const bf16x8 af = __builtin_bit_cast(bf16x8, (u32x4){alo.x, alo.y, ahi.x, ahi.y});
#pragma unroll
            for (int j = 0; j < 2; ++j) { LAS const unsigned char* vp = vimg + (2 * ch + j) * 8192 + kc * 1024 + voff; const s16x4 lo = att::vtr(vp), hh = att::vtr(vp + 512);
                const bf16x8 vf = (bf16x8){lo[0], lo[1], lo[2], lo[3], hh[0], hh[1], hh[2], hh[3]}; acc[j] = ATT_MFMA(af, vf, acc[j]); }
        }
        int hi_e = hi, r32_e = r32; asm volatile("" : "+v"(hi_e), "+v"(r32_e));
        const float* sbp = sb + g * 128 + 32 * tb + 4 * hi_e; bf16_t* hp = HC + (R0 + 32 * tb + 4 * hi_e) * 2048 + g * 128 + 64 * ch + r32_e;
        bf16_t uu[16][2]; float bsv[16];
#pragma unroll
        for (int r = 0; r < 16; ++r) { bsv[r] = sbp[att::crow(r, 0)];
#pragma unroll
            for (int j = 0; j < 2; ++j) uu[r][j] = hp[att::crow(r, 0) * 2048 + 32 * j]; }
        asm volatile("" ::: "memory");
#pragma unroll
        for (int r = 0; r < 16; ++r)
#pragma unroll
            for (int j = 0; j < 2; ++j) { const float u = __uint_as_float((unsigned)uu[r][j] << 16);
                hp[att::crow(r, 0) * 2048 + 32 * j] = (bf16_t)(cvt_pk_bf16(u * (acc[j][r] + bsv[r]), 0.f) & 0xffffu); }
        __syncthreads();
    }
}


#define XB_TMO      128
#define XB_XCNT(j)  (256  + 64 * (j))
#define XB_XSUB(j)  (1280 + 64 * (j))
#define XB_XGEN(j)  (2304 + 64 * (j))
#define XB_TOP      3328
#define XB_TOPGEN   3392
#define XCD_BAR_WORDS 3456
#define XB_SPIN_CAP (1u << 22)
__device__ __forceinline__ unsigned xb_ld(unsigned* p)              { return __hip_atomic_load(p, __ATOMIC_RELAXED, __HIP_MEMORY_SCOPE_AGENT); }
__device__ __forceinline__ unsigned xb_add(unsigned* p, unsigned v) { return __hip_atomic_fetch_add(p, v, __ATOMIC_RELAXED, __HIP_MEMORY_SCOPE_AGENT); }
__device__ __forceinline__ unsigned xb_xcc_id() { return (unsigned)__builtin_amdgcn_s_getreg((3 << 11) | 20) & 0xFu; }
#define XB_SPIN(cond, bar) do { unsigned _sp = 0; while (cond) { __builtin_amdgcn_s_sleep(1); \
    if ((++_sp & 255u) == 0u) { if (xb_ld(&(bar)[XB_TMO])) break; if (_sp > XB_SPIN_CAP) { atomicAdd(&(bar)[XB_TMO], 1u); break; } } } } while (0)
struct XcdBarrier { unsigned* bar; unsigned x; volatile LAS unsigned* st; };
__device__ __forceinline__ XcdBarrier xcd_barrier_post(unsigned* bar, volatile LAS unsigned* st) {
    XcdBarrier b; b.bar = bar; b.x = xb_xcc_id(); b.st = st;
    if (threadIdx.x == 0) (void)xb_add(&bar[XB_XCNT(b.x)], 1u);
    return b;
}
__device__ __forceinline__ void xcd_barrier_complete(unsigned* bar, unsigned x, unsigned& nloc, unsigned& nx) {
    const unsigned G = gridDim.x * gridDim.y * gridDim.z;
    unsigned sum, cnt, mine, sp = 0u;
    for (;;) {
        sum = 0u; cnt = 0u; mine = 0u;
#pragma unroll
        for (unsigned j = 0; j < 16; ++j) { const unsigned c = xb_ld(&bar[XB_XCNT(j)]); sum += c; cnt += (c > 0u) ? 1u : 0u; mine = (j == x) ? c : mine; }
        if (sum == G) break;
        __builtin_amdgcn_s_sleep(1);
        if ((++sp & 255u) == 0u) { if (xb_ld(&bar[XB_TMO])) break; if (sp > XB_SPIN_CAP) { atomicAdd(&bar[XB_TMO], 1u); break; } }
    }
    nloc = mine > 0u ? mine : 1u; nx = cnt > 0u ? cnt : 1u;
}
__device__ __forceinline__ void xcd_barrier(const XcdBarrier& b) {
    asm volatile("s_waitcnt vmcnt(0)" ::: "memory");
    __syncthreads();
    if (threadIdx.x == 0) {
        unsigned* bar = b.bar;
        __builtin_amdgcn_s_waitcnt(0);
        unsigned nloc = b.st[0], nx = b.st[1];
        if (nloc == 0u) { xcd_barrier_complete(bar, b.x, nloc, nx); b.st[0] = nloc; b.st[1] = nx; }
        const unsigned old = xb_add(&bar[XB_XSUB(b.x)], 1u);
        const unsigned gen = old / nloc;
        if (old + 1u == (gen + 1u) * nloc) {
            __builtin_amdgcn_fence(__ATOMIC_RELEASE, "agent");
            asm volatile("s_waitcnt vmcnt(0)" ::: "memory");
            const unsigned og = xb_add(&bar[XB_TOP], 1u);
            const unsigned tg = og / nx;
            if (og + 1u == (tg + 1u) * nx) xb_add(&bar[XB_TOPGEN], 1u);
            else XB_SPIN(xb_ld(&bar[XB_TOPGEN]) == tg, bar);
            __builtin_amdgcn_fence(__ATOMIC_ACQUIRE, "agent");
            xb_add(&bar[XB_XGEN(b.x)], 1u);
            asm volatile("s_waitcnt vmcnt(0)" ::: "memory");
        } else {
            XB_SPIN(xb_ld(&bar[XB_XGEN(b.x)]) == gen, bar);
            __builtin_amdgcn_fence(__ATOMIC_ACQUIRE, "agent");
            asm volatile("s_waitcnt vmcnt(0)" ::: "memory");
        }
    }
    __syncthreads();
}

__global__ void __launch_bounds__(512, 2) mk_fwd(Args a) {
    extern __shared__ __attribute__((aligned(16))) unsigned char lds_raw[];
    volatile LAS unsigned* bst = (volatile LAS unsigned*)((LAS unsigned char*)lds_raw + 134144);
    if (threadIdx.x < 2) bst[threadIdx.x] = 0u;
    __syncthreads();
    XcdBarrier gbar; gbar.bar = (unsigned*)a.ws; gbar.x = 0; gbar.st = bst;
    if (a.coop) gbar = xcd_barrier_post((unsigned*)a.ws, bst);
    const int G = gridDim.x, bx = blockIdx.x; const int vcu = (G % 8 == 0) ? (bx % 8) * (G / 8) + bx / 8 : bx;
    unsigned char* ws = a.ws;
    bf16_t* XB = (bf16_t*)(ws + WS_XB);
    for (int ph = a.ph_lo; ph < a.ph_hi; ++ph) {
        int tid_ = threadIdx.x; asm volatile("" : "+v"(tid_));
        Ctx C; C.lds = (LAS unsigned char*)lds_raw; C.tid = tid_; C.lane = C.tid & 63; C.wave = __builtin_amdgcn_readfirstlane(C.tid >> 6);
        C.gw = vcu * 8 + C.wave; C.NGW = G * 8;
        if (ph == 0) prologue(C, a);
        else {
            const int l = (ph - 1) / 11, s = (ph - 1) % 11;
            if (s == 0 || s == 8) {
                pg8::Gemm g{XB, (const bf16_t*)(ws + WS_WUP), T, 2 * FF, D}; pg8::StaticOrder S; S.init(T, 2 * FF, G, bx);
                pg8::EpiSwiGLU E{(bf16_t*)(ws + WS_ACT)};
                pg8::gemm_phase<pg8::EpiSwiGLU>(C.lds, g, S, E, C.tid);
            } else if (s == 1 || s == 9) {
                pg8::Gemm g{(const bf16_t*)(ws + WS_ACT), (const bf16_t*)(ws + WS_W2), T, D, FF}; pg8::StaticOrder S; S.init(T, D, G, bx);
                const bool raw = (l == 0 && s == 1); const int pli = (s == 1) ? l * 3 - 1 : l * 3 + 1;
                pg8::EpiResid E{raw ? a.in[0] : a.out, a.out, 0.5f, raw ? nullptr : (const f32x2*)(ws + WS_STATS), a.in[14] + (raw ? 0 : pli) * D, a.in[15] + (raw ? 0 : pli) * D};
                pg8::gemm_phase<pg8::EpiResid>(C.lds, g, S, E, C.tid);
            } else if (s == 2 || s == 7 || s == 10) {
                const int li = (s == 2) ? 0 : (s == 7) ? 1 : 2;
                ln_rows(C, a.out, XB, a.in[14] + (l * 3 + li) * D, a.in[15] + (l * 3 + li) * D, (f32x2*)(ws + WS_STATS), l == DEPTH - 1 && s == 10);
                if (s == 2) conv_mixer(C, a, l); else if (s == 7) conv_ffn(C, a, l, 1); else if (l + 1 < DEPTH) conv_ffn(C, a, l + 1, 0);
            } else if (s == 3) {
                pg8::Gemm g{XB, (const bf16_t*)(ws + WS_WIN), T, INW, D}; pg8::StaticOrder S; S.init(T, INW, G, bx);
                pg8::EpiInProj E{(bf16_t*)(ws + WS_HCAT), (bf16_t*)(ws + WS_V), (bf16_t*)(ws + WS_K), (bf16_t*)(ws + WS_VAL), (bf16_t*)(ws + WS_GA), (bf16_t*)(ws + WS_GB), a.in[2] + l * 2 * D, (const float*)(ws + WS_ROPE)};
                pg8::gemm_phase<pg8::EpiInProj>(C.lds, g, S, E, C.tid);
            } else if (s == 4) {
                const float* lf = a.in[7] + l * 256;
                const float s1 = wave_sum(lf[C.lane] * lf[64 + C.lane]), s2 = wave_sum(lf[128 + C.lane] * lf[192 + C.lane]);
                const float li = a.lam_init[l];
                att::Params P{(const bf16_t*)(ws + WS_HCAT) + 1024, (const bf16_t*)(ws + WS_K), (const bf16_t*)(ws + WS_VAL), (bf16_t*)(ws + WS_HCAT) + 1024, a.in[8] + l * 128, expf(s1) - expf(s2) + li, 1.0f - li};
                const int niter = (G == 256) ? 8 : (2048 + G - 1) / G;
                for (int i = 0; i < niter; ++i) {
                    int bh, qb;
                    if (G == 256) { const int base = 32 * ((i >> 1) & 1) + (vcu & 31); bh = 2 * (vcu >> 5) + (i >> 2); qb = (i & 1) ? base : 127 - base; }
                    else { const int u = bx + i * G; if (u >= 2048) break; bh = u >> 7; qb = 127 - (u & 127); }
                    att::unit(bh >> 3, bh & 7, qb, P, C.lds, C.tid);
                }
                for (int n = bx; n < 256; n += G) sgu_chunk(C, a, l, n);
            } else if (s == 5) {
                pg8::Gemm g{(const bf16_t*)(ws + WS_HCAT), (const bf16_t*)(ws + WS_WBR), T, D, 2 * D}; pg8::StaticOrder S; S.init(T, D, G, bx);
                pg8::EpiMerge E{(const bf16_t*)(ws + WS_GA), (const bf16_t*)(ws + WS_GB), (bf16_t*)(ws + WS_V)};
                pg8::gemm_phase<pg8::EpiMerge>(C.lds, g, S, E, C.tid);
            } else {
                pg8::Gemm g{(const bf16_t*)(ws + WS_V), (const bf16_t*)(ws + WS_WOUT), T, D, D}; pg8::StaticOrder S; S.init(T, D, G, bx);
                pg8::EpiResid E{a.out, a.out, 1.0f, (const f32x2*)(ws + WS_STATS), a.in[14] + (l * 3) * D, a.in[15] + (l * 3) * D};
                pg8::gemm_phase<pg8::EpiResid>(C.lds, g, S, E, C.tid);
            }
        }
        if (ph + 1 < a.ph_hi) { if (a.coop) { if (a.coop == 2) cg::this_grid().sync(); else xcd_barrier(gbar); } }
    }
}

constexpr int LDS_BYTES = 135168;

extern "C" void kernel_launch(void* const* d_in, const int* in_sizes, int n_in, void* d_out, int out_size, void* d_ws, size_t ws_size, hipStream_t stream) {
    static int grid = 0;
    if (grid == 0) {
        if (n_in != 16 || out_size != T * D || ws_size < WS_END) { fprintf(stderr, "kernel_launch: unexpected shapes (n_in %d out %d ws %zu need %zu)\n", n_in, out_size, ws_size, (size_t)WS_END); grid = -1; return; }
        int dev = 0, cus = 0, per_cu = 0;
        hipGetDevice(&dev); hipDeviceGetAttribute(&cus, hipDeviceAttributeMultiprocessorCount, dev);
        if (hipFuncSetAttribute((const void*)mk_fwd, hipFuncAttributeMaxDynamicSharedMemorySize, LDS_BYTES) != hipSuccess) { fprintf(stderr, "kernel_launch: hipFuncSetAttribute failed\n"); grid = -1; return; }
        if (hipOccupancyMaxActiveBlocksPerMultiprocessor(&per_cu, (const void*)mk_fwd, 512, LDS_BYTES) != hipSuccess || per_cu < 1) per_cu = 1;
        (void)hipGetLastError();
        grid = cus * per_cu;
    }
    if (grid < 0) return;
    (void)hipMemsetAsync(d_ws, 0, 16384, stream);
    Args a{};
    for (int i = 0; i < 16; ++i) a.in[i] = (const float*)d_in[i];
    a.out = (float*)d_out; a.ws = (unsigned char*)d_ws;
    for (int j = 0; j < 32; ++j) a.invf[j] = (float)pow(10000.0, -(double)j / 32.0);
    for (int l = 0; l < DEPTH; ++l) a.lam_init[l] = (float)(0.8 - 0.6 * exp(-0.3 * (double)l));
#if MK_COOP
    a.ph_lo = 0; a.ph_hi = NPH; a.coop = 1;
    void* args[] = {&a};
    hipError_t e = hipLaunchCooperativeKernel((const void*)mk_fwd, dim3(grid), dim3(512), args, LDS_BYTES, stream);
    if (e != hipSuccess) fprintf(stderr, "cooperative launch failed: %s (grid %d)\n", hipGetErrorString(e), grid);
#else
    a.coop = 0;
    for (int ph = 0; ph < NPH; ++ph) { a.ph_lo = ph; a.ph_hi = ph + 1; hipLaunchKernelGGL(mk_fwd, dim3(grid), dim3(512), LDS_BYTES, stream, a); }
#endif
}
```

```cpp
#include <hip/hip_runtime.h>
#include <hip/hip_cooperative_groups.h>
#include <cstdio>
#include <cstdint>
#include <cmath>
namespace cg = cooperative_groups;

#ifndef MK_COOP
#define MK_COOP 1
#endif

#define LAS __attribute__((address_space(3)))
typedef unsigned short bf16_t;
typedef short bf16x8 __attribute__((ext_vector_type(8)));
typedef short s16x4 __attribute__((ext_vector_type(4)));
typedef float f32x2 __attribute__((ext_vector_type(2)));
typedef float f32x4 __attribute__((ext_vector_type(4)));
typedef float f32x16 __attribute__((ext_vector_type(16)));
typedef unsigned u32x2 __attribute__((ext_vector_type(2)));
typedef unsigned u32x4 __attribute__((ext_vector_type(4)));

constexpr int SEQ = 16384, NB = 2, T = NB * SEQ, D = 1024, FF = 2816, INW = 7168, DEPTH = 4;
constexpr float LN_EPS = 1e-5f;
constexpr float ALPHA = 1.681792830507429f;
constexpr float C2 = 0.125f * 1.4426950408889634f;
constexpr int NPH = 1 + 11 * DEPTH;

constexpr size_t MiB = 1u << 20;
constexpr size_t WS_STATS = 64 * 1024;
constexpr size_t WS_ROPE = 1 * MiB;
constexpr size_t WS_SGUW = 5 * MiB;
constexpr size_t WS_XB = 8 * MiB;
constexpr size_t WS_WIN = 72 * MiB, WS_WBR = 86 * MiB, WS_WOUT = 90 * MiB;
constexpr size_t WS_BIG = 92 * MiB;
constexpr size_t WS_HCAT = WS_BIG;
constexpr size_t WS_V = WS_BIG + 128 * MiB;
constexpr size_t WS_K = WS_BIG + 192 * MiB;
constexpr size_t WS_VAL = WS_BIG + 256 * MiB;
constexpr size_t WS_GA = WS_BIG + 320 * MiB;
constexpr size_t WS_GB = WS_BIG + 384 * MiB;
constexpr size_t WS_ACT = WS_BIG;
constexpr size_t WS_WUP = WS_BIG + 320 * MiB;
constexpr size_t WS_W2 = WS_BIG + 332 * MiB;
constexpr size_t WS_END = WS_BIG + 448 * MiB;

typedef __bf16 bf16x2_t __attribute__((ext_vector_type(2)));
__device__ __forceinline__ unsigned cvt_pk_bf16(float lo, float hi) { f32x2 v = {lo, hi}; bf16x2_t b = __builtin_convertvector(v, bf16x2_t); return __builtin_bit_cast(unsigned, b); }
__device__ __forceinline__ unsigned cvtpk_s(float lo, float hi) { return cvt_pk_bf16(lo, hi); }
__device__ __forceinline__ float bf_lo(unsigned w) { return __uint_as_float(w << 16); }
__device__ __forceinline__ float bf_hi(unsigned w) { return __uint_as_float(w & 0xffff0000u); }
__device__ __forceinline__ float wave_sum(float v) {
#pragma unroll
    for (int o = 1; o < 64; o <<= 1) v += __shfl_xor(v, o);
    return v;
}
__device__ __forceinline__ f32x2 gelu_pk(f32x2 v) {
    const f32x2 av = __builtin_elementwise_abs(v), d = av * 0.2316418882f + 1.0f;
    f32x2 t; t.x = __builtin_amdgcn_rcpf(d.x); t.y = __builtin_amdgcn_rcpf(d.y);
    f32x2 q = t * 0.5307027145f + (-0.7265760135f); q = q * t + 0.7107068705f; q = q * t + (-0.142248368f); q = q * t + 0.127414796f; q = q * t;
    const f32x2 s = (v * v) * (-0.72134752044f);
    f32x2 e; e.x = __builtin_amdgcn_exp2f(s.x); e.y = __builtin_amdgcn_exp2f(s.y);
    const f32x2 m = v * (q * e), r = v - m;
    f32x2 o; o.x = v.x < 0.f ? m.x : r.x; o.y = v.y < 0.f ? m.y : r.y; return o;
}
__device__ __forceinline__ float sigmoidf_(float x) { return __builtin_amdgcn_rcpf(1.0f + __builtin_amdgcn_exp2f(-1.4426950408889634f * x)); }

namespace pg8 {
constexpr int BM = 256, BK = 64, HALF = 128, HTB = HALF * BK * 2, STAGE_BYTES = 8 * HTB, NXCD = 8, WGM = 4;
__host__ __device__ __forceinline__ int lds_byte(int r, int c) { const int st = (r >> 4) * 2 + (c >> 5), rr = r & 15, cc = c & 31, ob = rr * 64 + cc * 2; return st * 1024 + (ob ^ (((ob >> 9) & 1) << 5)); }
__host__ __device__ __forceinline__ void stage_rc(int b, int& R, int& C) { const int st = b / 1024, sb = b % 1024, swz = sb ^ (((sb >> 9) & 1) << 5); R = (st >> 1) * 16 + swz / 64; C = (st & 1) * 32 + (swz % 64) / 2; }
__host__ __device__ __forceinline__ int perm32(int rho) { const int n = rho >> 4, i = rho & 15; return 8 * (i >> 2) + 4 * n + (i & 3); }
struct Unit { int pm, pn; };
struct Gemm { const bf16_t* A; const bf16_t* Bt; int M, N, K; };
struct StaticOrder {
    int nM, nN, nwg, G, c;
    __host__ __device__ void init(int M, int N, int G_, int c_) { nM = M / BM; nN = N / BM; nwg = nM * nN; G = G_; c = c_; }
    __host__ __device__ bool next(int i, Unit& u) const {
        const long L = (long)i * G + c; if (L >= nwg) return false;
        int wgid = (int)L; { const int q = nwg / NXCD, r = nwg % NXCD, xcd = wgid % NXCD, off = wgid / NXCD; wgid = (xcd < r ? xcd * (q + 1) : r * (q + 1) + (xcd - r) * q) + off; }
        const int nig = WGM * nN, gid = wgid / nig, fm = gid * WGM, gsz = (nM - fm) < WGM ? (nM - fm) : WGM;
        u.pm = fm + ((wgid % nig) % gsz); u.pn = (wgid % nig) / gsz; return true;
    }
};
typedef f32x4 Acc[2][2][4][2];

template <class Epi, bool SP2 = true, bool ALIGN_EPI = true>
__device__ __forceinline__ void gemm_phase(LAS unsigned char* lds, const Gemm g, const StaticOrder& S, const Epi& E, const int tid) {
    const int wid = __builtin_amdgcn_readfirstlane(tid >> 6), lane = tid & 63, wr = wid >> 2, wc = wid & 3, fr = lane & 15, fq = lane >> 4;
    const int K = g.K, nt = K / BK;
    unsigned voffA[2], voffB[2];
#pragma unroll
    for (int i = 0; i < 2; ++i) { int R, C; stage_rc(tid * 16 + i * 8192, R, C); const int Rb = Epi::PERM ? ((R & ~31) + perm32(R & 31)) : R;
        voffA[i] = (unsigned)(R * K + C) * 2u; voffB[i] = (unsigned)(Rb * K + C) * 2u; }
    const size_t kstep = (size_t)(BK * 2);
    const size_t hstep = (size_t)HALF * K * 2;
    const size_t tstep = 2 * hstep;
    const unsigned ldsw = (unsigned)wid * 1024u;
    const int aoff = lds_byte(wr * 64 + fr, fq * 8), boff = lds_byte(wc * 32 + fr, fq * 8);
#define PG8_SA(b, h) (((b) * 2 + (h)) * HTB)
#define PG8_SB(b, h) ((4 + (b) * 2 + (h)) * HTB)
#define PG8_STAGE(bufoff, gbase, voff) do { _Pragma("unroll") for (int _i = 0; _i < 2; ++_i) \
        __builtin_amdgcn_global_load_lds((const unsigned*)((const char*)(gbase) + (voff)[_i]), (LAS unsigned*)(lds + (bufoff) + ldsw + _i * 8192), 16, 0, 0); } while (0)
#define PG8_LDA(dst, b, h) do { _Pragma("unroll") for (int m = 0; m < 4; ++m) _Pragma("unroll") for (int k = 0; k < 2; ++k) dst[m][k] = *(const LAS bf16x8*)(lds + PG8_SA(b, h) + aoff + m * 2048 + k * 1024); } while (0)
#define PG8_LDB(dst, b, h) do { _Pragma("unroll") for (int n = 0; n < 2; ++n) _Pragma("unroll") for (int k = 0; k < 2; ++k) dst[n][k] = *(const LAS bf16x8*)(lds + PG8_SB(b, h) + boff + n * 2048 + k * 1024); } while (0)
#define PG8_MMA(ai, bj, At, Bt) do { __builtin_amdgcn_s_setprio(1); _Pragma("unroll") for (int m = 0; m < 4; ++m) _Pragma("unroll") for (int n = 0; n < 2; ++n) _Pragma("unroll") for (int k = 0; k < 2; ++k) \
        acc[ai][bj][m][n] = __builtin_amdgcn_mfma_f32_16x16x32_bf16(Bt[n][k], At[m][k], acc[ai][bj][m][n], 0, 0, 0); __builtin_amdgcn_s_setprio(0); } while (0)
#define PG8_WAIT_V(n) asm volatile("s_waitcnt vmcnt(" #n ")" ::: "memory")
#define PG8_WAIT_L(n) asm volatile("s_waitcnt lgkmcnt(" #n ")" ::: "memory")
#define PG8_BAR __builtin_amdgcn_s_barrier()
#define PG8_SCHED __builtin_amdgcn_sched_barrier(0)
    Unit cur, nxt; int ui = 0;
    if (!S.next(0, cur)) return;
    Acc acc;
#pragma unroll
    for (int a = 0; a < 2; ++a)
#pragma unroll
        for (int b = 0; b < 2; ++b)
#pragma unroll
            for (int m = 0; m < 4; ++m)
#pragma unroll
                for (int n = 0; n < 2; ++n) acc[a][b][m][n] = (f32x4){0.f, 0.f, 0.f, 0.f};
    bf16x8 At[4][2], B0[2][2], B1[2][2];
    const char* cA = (const char*)g.A + (size_t)cur.pm * tstep; const char* cB = (const char*)g.Bt + (size_t)cur.pn * tstep;
    if constexpr (SP2) {
        PG8_STAGE(PG8_SB(0, 0), cB, voffB); PG8_STAGE(PG8_SB(0, 1), cB + hstep, voffB); PG8_STAGE(PG8_SA(0, 0), cA, voffA); PG8_STAGE(PG8_SA(0, 1), cA + hstep, voffA);
        if (wr == 1) PG8_BAR;
        PG8_WAIT_V(2); PG8_BAR;
        PG8_STAGE(PG8_SB(1, 0), cB + kstep, voffB); PG8_STAGE(PG8_SA(1, 0), cA + kstep, voffA); PG8_STAGE(PG8_SB(1, 1), cB + hstep + kstep, voffB);
        PG8_WAIT_V(6); PG8_BAR;
    } else {
        PG8_STAGE(PG8_SB(0, 0), cB, voffB); PG8_STAGE(PG8_SA(0, 0), cA, voffA); PG8_STAGE(PG8_SB(0, 1), cB + hstep, voffB); PG8_STAGE(PG8_SA(0, 1), cA + hstep, voffA);
        if (wr == 1) PG8_BAR;
        PG8_WAIT_V(4); PG8_BAR;
        PG8_STAGE(PG8_SB(1, 0), cB + kstep, voffB); PG8_STAGE(PG8_SA(1, 0), cA + kstep, voffA); PG8_STAGE(PG8_SB(1, 1), cB + hstep + kstep, voffB);
        PG8_WAIT_V(6); PG8_BAR;
    }
    for (;;) {
        const bool has_next = S.next(ui + 1, nxt);
        const char* nA = has_next ? (const char*)g.A + (size_t)nxt.pm * tstep : cA; const char* nB = has_next ? (const char*)g.Bt + (size_t)nxt.pn * tstep : cB;
        constexpr int NHALF = Epi::HOOK ? 2 : 1; const int tper = nt / NHALF;
        for (int hh = 0; hh < NHALF; ++hh) {
        if constexpr (Epi::HOOK) { if (hh == 1) { int fr_e = fr, fq_e = fq; asm volatile("" : "+v"(fr_e), "+v"(fq_e)); E.mid(acc, cur, wr, wc, fr_e, fq_e); } }
        for (int t = hh * tper; t < (hh + 1) * tper; t += 2) {
            const bool last = (t == nt - 2);
            const char* a1 = cA + (size_t)(t + 1) * kstep;
            const char* a2 = last ? nA : cA + (size_t)(t + 2) * kstep; const char* b2 = last ? nB : cB + (size_t)(t + 2) * kstep;
            const char* a3 = a2 + kstep; const char* b3 = b2 + kstep;
            if constexpr (SP2) {
            PG8_LDB(B0, 0, 0); PG8_LDB(B1, 0, 1); PG8_SCHED; PG8_LDA(At, 0, 0); PG8_STAGE(PG8_SA(1, 1), a1 + hstep, voffA);
            PG8_WAIT_V(8); PG8_WAIT_L(0); PG8_BAR; PG8_MMA(0, 0, At, B0); PG8_MMA(0, 1, At, B1); PG8_BAR; PG8_SCHED;
            PG8_LDA(At, 0, 1); PG8_STAGE(PG8_SB(0, 0), b2, voffB); PG8_STAGE(PG8_SB(0, 1), b2 + hstep, voffB); PG8_STAGE(PG8_SA(0, 0), a2, voffA);
            PG8_WAIT_V(8); PG8_WAIT_L(0); PG8_BAR; PG8_MMA(1, 0, At, B0); PG8_MMA(1, 1, At, B1); PG8_BAR; PG8_SCHED;
            PG8_LDB(B0, 1, 0); PG8_LDB(B1, 1, 1); PG8_SCHED; PG8_LDA(At, 1, 0); PG8_STAGE(PG8_SA(0, 1), a2 + hstep, voffA);
            PG8_WAIT_V(8); PG8_WAIT_L(0); PG8_BAR; PG8_MMA(0, 0, At, B0); PG8_MMA(0, 1, At, B1); PG8_BAR; PG8_SCHED;
            PG8_LDA(At, 1, 1); PG8_STAGE(PG8_SB(1, 0), b3, voffB); PG8_STAGE(PG8_SB(1, 1), b3 + hstep, voffB); PG8_STAGE(PG8_SA(1, 0), a3, voffA);
            PG8_WAIT_V(8); PG8_WAIT_L(0); PG8_BAR; PG8_MMA(1, 0, At, B0); PG8_MMA(1, 1, At, B1); PG8_BAR; PG8_SCHED;
            } else {
            PG8_LDB(B0, 0, 0); PG8_SCHED; PG8_LDA(At, 0, 0); PG8_STAGE(PG8_SA(1, 1), a1 + hstep, voffA);
            PG8_WAIT_L(8); PG8_BAR; PG8_WAIT_L(0); PG8_MMA(0, 0, At, B0); PG8_BAR; PG8_SCHED;
            PG8_LDB(B1, 0, 1); PG8_STAGE(PG8_SB(0, 0), b2, voffB);
            PG8_BAR; PG8_WAIT_L(0); PG8_MMA(0, 1, At, B1); PG8_BAR;
            PG8_LDA(At, 0, 1); PG8_STAGE(PG8_SA(0, 0), a2, voffA);
            PG8_BAR; PG8_WAIT_L(0); PG8_MMA(1, 0, At, B0); PG8_BAR; PG8_SCHED;
            PG8_STAGE(PG8_SB(0, 1), b2 + hstep, voffB);
            PG8_WAIT_V(6); PG8_BAR; PG8_MMA(1, 1, At, B1); PG8_BAR;
            PG8_LDB(B0, 1, 0); PG8_SCHED; PG8_LDA(At, 1, 0); PG8_STAGE(PG8_SA(0, 1), a2 + hstep, voffA);
            PG8_WAIT_L(8); PG8_BAR; PG8_WAIT_L(0); PG8_MMA(0, 0, At, B0); PG8_BAR; PG8_SCHED;
            PG8_LDB(B1, 1, 1); PG8_STAGE(PG8_SB(1, 0), b3, voffB);
            PG8_BAR; PG8_WAIT_L(0); PG8_MMA(0, 1, At, B1); PG8_BAR;
            PG8_LDA(At, 1, 1); PG8_STAGE(PG8_SA(1, 0), a3, voffA);
            PG8_BAR; PG8_WAIT_L(0); PG8_MMA(1, 0, At, B0); PG8_BAR; PG8_SCHED;
            PG8_STAGE(PG8_SB(1, 1), b3 + hstep, voffB);
            PG8_WAIT_V(6); PG8_BAR; PG8_MMA(1, 1, At, B1); PG8_BAR;
            }
        }
        }
        if constexpr (ALIGN_EPI) { if (wr == 0) PG8_BAR; }
        { int fr_e = fr, fq_e = fq; asm volatile("" : "+v"(fr_e), "+v"(fq_e)); E(acc, cur, wr, wc, fr_e, fq_e); }
        if (!has_next) break;
#pragma unroll
        for (int a = 0; a < 2; ++a)
#pragma unroll
            for (int b = 0; b < 2; ++b)
#pragma unroll
                for (int m = 0; m < 4; ++m)
#pragma unroll
                    for (int n = 0; n < 2; ++n) acc[a][b][m][n] = (f32x4){0.f, 0.f, 0.f, 0.f};
        cur = nxt; cA = nA; cB = nB; ++ui;
        if constexpr (ALIGN_EPI) { if (wr == 1) PG8_BAR; }
    }
    PG8_WAIT_V(0);
    if constexpr (!ALIGN_EPI) { if (wr == 0) PG8_BAR; }
    PG8_BAR;
#undef PG8_SA
#undef PG8_SB
#undef PG8_STAGE
#undef PG8_LDA
#undef PG8_LDB
#undef PG8_MMA
#undef PG8_WAIT_V
#undef PG8_WAIT_L
#undef PG8_BAR
#undef PG8_SCHED
}

struct EpiSwiGLU {
    static constexpr bool PERM = true, HOOK = false;
    bf16_t* O;
    __device__ __forceinline__ void mid(Acc&, const Unit&, int, int, int, int) const {}
    __device__ __forceinline__ void operator()(const Acc& acc, const Unit& u, int wr, int wc, int fr, int fq) const {
        const int row0 = u.pm * BM + wr * 64 + fr, col0 = u.pn * 128 + wc * 32 + 8 * fq;
#pragma unroll
        for (int ai = 0; ai < 2; ++ai)
#pragma unroll
            for (int m = 0; m < 4; ++m) {
                float r[8];
#pragma unroll
                for (int n = 0; n < 2; ++n)
#pragma unroll
                    for (int i = 0; i < 4; ++i) { const float a = acc[ai][0][m][n][i], b = acc[ai][1][m][n][i]; r[4 * n + i] = a * b * sigmoidf_(a); }
                u32x4 w; w.x = cvt_pk_bf16(r[0], r[1]); w.y = cvt_pk_bf16(r[2], r[3]); w.z = cvt_pk_bf16(r[4], r[5]); w.w = cvt_pk_bf16(r[6], r[7]);
                *(u32x4*)(O + (size_t)(row0 + ai * HALF + m * 16) * FF + col0) = w;
            }
    }
};
struct EpiResid {
    static constexpr bool PERM = false, HOOK = false;
    const float* base; float* out; float scale; const f32x2* st; const float* g; const float* b;
    __device__ __forceinline__ void mid(Acc&, const Unit&, int, int, int, int) const {}
    __device__ __forceinline__ void operator()(const Acc& acc, const Unit& u, int wr, int wc, int fr, int fq) const {
        const int row0 = u.pm * BM + wr * 64 + fr, col0 = u.pn * BM + wc * 32 + 4 * fq;
#pragma unroll
        for (int ai = 0; ai < 2; ++ai)
#pragma unroll
            for (int mh = 0; mh < 2; ++mh) {
                f32x4 pre[2][2][2]; f32x2 sv[2];
#pragma unroll
                for (int mm = 0; mm < 2; ++mm) { const int row = row0 + ai * HALF + (2 * mh + mm) * 16; const size_t off = (size_t)row * D + col0;
                    sv[mm] = st ? st[row] : (f32x2){0.f, 1.f};
#pragma unroll
                    for (int bj = 0; bj < 2; ++bj)
#pragma unroll
                        for (int n = 0; n < 2; ++n) pre[mm][bj][n] = *(const f32x4*)(base + off + bj * HALF + n * 16); }
                asm volatile("" ::: "memory");
#pragma unroll
                for (int bj = 0; bj < 2; ++bj)
#pragma unroll
                    for (int n = 0; n < 2; ++n) { f32x4 gv = (f32x4){ALPHA, ALPHA, ALPHA, ALPHA}, bv = (f32x4){0.f, 0.f, 0.f, 0.f};
                        if (st) { gv = *(const f32x4*)(g + col0 + bj * HALF + n * 16) * ALPHA; bv = *(const f32x4*)(b + col0 + bj * HALF + n * 16) * ALPHA; }
#pragma unroll
                        for (int mm = 0; mm < 2; ++mm) { const int m = 2 * mh + mm; const size_t off = (size_t)(row0 + ai * HALF + m * 16) * D + col0;
                            *(f32x4*)(out + off + bj * HALF + n * 16) = ((pre[mm][bj][n] - sv[mm].x) * sv[mm].y) * gv + bv + acc[ai][bj][m][n] * scale; } }
                asm volatile("" ::: "memory");
            }
    }
};
struct EpiMerge {
    static constexpr bool PERM = true, HOOK = true;
    const bf16_t* GA; const bf16_t* GB; bf16_t* O;
    __device__ __forceinline__ void mid(Acc& acc, const Unit& u, int wr, int wc, int fr, int fq) const {
        int row0 = u.pm * BM + wr * 64 + fr; const int col0 = u.pn * BM + wc * 32 + 8 * fq; asm volatile("" : "+v"(row0));
#pragma unroll
        for (int ai = 0; ai < 2; ++ai) {
            u32x4 ga[4][2], gb[4][2];
#pragma unroll
            for (int m = 0; m < 4; ++m)
#pragma unroll
                for (int bj = 0; bj < 2; ++bj) { const size_t off = (size_t)(row0 + ai * HALF + m * 16) * D + col0 + bj * HALF; ga[m][bj] = *(const u32x4*)(GA + off); gb[m][bj] = *(const u32x4*)(GB + off); }
            asm volatile("" ::: "memory");
#pragma unroll
            for (int m = 0; m < 4; ++m)
#pragma unroll
                for (int bj = 0; bj < 2; ++bj) {
#pragma unroll
                    for (int k = 0; k < 4; ++k) { const float rl = bf_lo(ga[m][bj][k]) * __builtin_amdgcn_rcpf(bf_lo(gb[m][bj][k])), rh = bf_hi(ga[m][bj][k]) * __builtin_amdgcn_rcpf(bf_hi(gb[m][bj][k]));
                        acc[ai][bj][m][k >> 1][(k & 1) * 2] *= rl; acc[ai][bj][m][k >> 1][(k & 1) * 2 + 1] *= rh; } }
            asm volatile("" ::: "memory");
        }
    }
    __device__ __forceinline__ void operator()(const Acc& acc, const Unit& u, int wr, int wc, int fr, int fq) const {
        const int row0 = u.pm * BM + wr * 64 + fr, col0 = u.pn * BM + wc * 32 + 8 * fq;
#pragma unroll
        for (int ai = 0; ai < 2; ++ai) {
            u32x4 gb[4][2];
#pragma unroll
            for (int m = 0; m < 4; ++m)
#pragma unroll
                for (int bj = 0; bj < 2; ++bj) gb[m][bj] = *(const u32x4*)(GB + (size_t)(row0 + ai * HALF + m * 16) * D + col0 + bj * HALF);
            asm volatile("" ::: "memory");
#pragma unroll
            for (int m = 0; m < 4; ++m)
#pragma unroll
                for (int bj = 0; bj < 2; ++bj) { u32x4 w;
#pragma unroll
                    for (int k = 0; k < 4; ++k) w[k] = cvt_pk_bf16(acc[ai][bj][m][k >> 1][(k & 1) * 2] * bf_lo(gb[m][bj][k]), acc[ai][bj][m][k >> 1][(k & 1) * 2 + 1] * bf_hi(gb[m][bj][k]));
                    *(u32x4*)(O + (size_t)(row0 + ai * HALF + m * 16) * D + col0 + bj * HALF) = w; }
            asm volatile("" ::: "memory");
        }
    }
};
struct EpiInProj {
    static constexpr bool PERM = true, HOOK = false;
    bf16_t* HCAT; bf16_t* VB; bf16_t* KB; bf16_t* VALB; bf16_t* GA; bf16_t* GB; const float* gate_b; const float* rope;
    __device__ __forceinline__ void mid(Acc&, const Unit&, int, int, int, int) const {}
    __device__ __forceinline__ void operator()(const Acc& acc, const Unit& u, int wr, int wc, int fr, int fq) const {
        const int row0 = u.pm * BM + wr * 64 + fr; const int sec = u.pn >> 2, tl = u.pn & 3;
        if (sec == 2 || sec == 3) {
            bf16_t* dst = (sec == 2) ? (HCAT + 1024) : KB; const int pitch = (sec == 2) ? 2048 : 1024; const float sc = (sec == 2) ? C2 : 1.0f;
            const int col0 = tl * 256 + wc * 64 + 8 * fq;
#pragma unroll
            for (int ai = 0; ai < 2; ++ai)
#pragma unroll
                for (int m = 0; m < 4; ++m) { const int row = row0 + ai * HALF + m * 16; const float* cs = rope + (size_t)(row & (SEQ - 1)) * 64 + 8 * fq;
                    u32x4 w1, w2;
#pragma unroll
                    for (int n = 0; n < 2; ++n) { const f32x4 c = *(const f32x4*)(cs + 4 * n) * sc, s = *(const f32x4*)(cs + 32 + 4 * n) * sc;
                        const f32x4 x1 = acc[ai][0][m][n], x2 = acc[ai][1][m][n]; const f32x4 o1 = x1 * c - x2 * s, o2 = x2 * c + x1 * s;
                        w1[2 * n] = cvt_pk_bf16(o1[0], o1[1]); w1[2 * n + 1] = cvt_pk_bf16(o1[2], o1[3]); w2[2 * n] = cvt_pk_bf16(o2[0], o2[1]); w2[2 * n + 1] = cvt_pk_bf16(o2[2], o2[3]); }
                    bf16_t* p = (sec == 2) ? dst + (size_t)row * pitch + col0
                                           : dst + ((size_t)(((row >> 14) * 8 + tl * 2 + (wc >> 1)) * SEQ + (row & (SEQ - 1)))) * 128 + (wc & 1) * 64 + 8 * fq;
                    *(u32x4*)p = w1; *(u32x4*)(p + 32) = w2; asm volatile("" ::: "memory"); }
            return;
        }
        bf16_t* dst; int pitch; int mode;
        if (sec == 0) { dst = HCAT; pitch = 2048; mode = 1; } else if (sec == 1) { dst = VB; pitch = 1024; mode = 1; } else if (sec == 4) { dst = VALB; pitch = 1024; mode = 0; }
        else if (sec == 5) { dst = GA; pitch = 1024; mode = 2; } else { dst = GB; pitch = 1024; mode = 2; }
        const int col0 = tl * 256 + wc * 32 + 8 * fq;
        const float* gbp = gate_b + (mode == 2 ? (sec - 5) * 1024 + col0 : 0);
#pragma unroll
        for (int ai = 0; ai < 2; ++ai)
#pragma unroll
            for (int m = 0; m < 4; ++m) { const int row = row0 + ai * HALF + m * 16; bf16_t* rowp = dst + (size_t)row * pitch + col0;
                if (mode == 0) rowp = dst + ((size_t)(((row >> 14) * 8 + tl * 2) * SEQ + (row & (SEQ - 1)))) * 128 + wc * 32 + 8 * fq;
#pragma unroll
                for (int bj = 0; bj < 2; ++bj) { f32x4 v0 = acc[ai][bj][m][0], v1 = acc[ai][bj][m][1];
                    if (mode == 1) { f32x2 a = gelu_pk((f32x2){v0[0], v0[1]}), b = gelu_pk((f32x2){v0[2], v0[3]}), c = gelu_pk((f32x2){v1[0], v1[1]}), d = gelu_pk((f32x2){v1[2], v1[3]});
                        v0 = (f32x4){a.x, a.y, b.x, b.y}; v1 = (f32x4){c.x, c.y, d.x, d.y}; }
                    else if (mode == 2) { v0 = v0 + *(const f32x4*)(gbp + bj * HALF); v1 = v1 + *(const f32x4*)(gbp + bj * HALF + 4);
#pragma unroll
                        for (int i = 0; i < 4; ++i) { v0[i] = sigmoidf_(v0[i]); v1[i] = sigmoidf_(v1[i]); } }
                    u32x4 w; w.x = cvt_pk_bf16(v0[0], v0[1]); w.y = cvt_pk_bf16(v0[2], v0[3]); w.z = cvt_pk_bf16(v1[0], v1[1]); w.w = cvt_pk_bf16(v1[2], v1[3]);
                    *(u32x4*)(rowp + (mode == 0 ? (size_t)bj * SEQ * 128 : (size_t)bj * HALF)) = w; } }
    }
};
}

namespace att {
__device__ __forceinline__ int crow(int r, int hi) { return (r & 3) + 8 * (r >> 2) + 4 * hi; }
__device__ __forceinline__ void glds16(const void* gsrc, unsigned lds_dst) { unsigned keep;
    asm volatile("s_mov_b32 %0, m0\n\ts_mov_b32 m0, %2\n\ts_nop 0\n\tglobal_load_lds_dwordx4 %1, off\n\ts_mov_b32 m0, %0" : "=&s"(keep) : "v"(gsrc), "s"(lds_dst) : "memory"); }
typedef short v4i16_t __attribute__((ext_vector_type(4)));
__device__ __forceinline__ s16x4 vtr(LAS const unsigned char* p) { return __builtin_bit_cast(s16x4, __builtin_amdgcn_ds_read_tr16_b64_v4i16((LAS v4i16_t*)p)); }
#define ATT_MFMA(a, b, c) __builtin_amdgcn_mfma_f32_32x32x16_bf16(a, b, c, 0, 0, 0)
constexpr int STAGE = 32768;
constexpr int NSTAGE = 4;
constexpr int XOFF = 0;
constexpr int XRG = 32 * 136;
constexpr int WSOFF = NSTAGE * STAGE;

__device__ __forceinline__ float fadd_s(float a, float b) { float r = a + b; asm("" : "+v"(r)); return r; }
struct DmaT { const bf16_t* k; const bf16_t* v; unsigned dk, dv; bool on; };
__device__ __forceinline__ void dma_piece(const DmaT& d, int i) {
    if (!d.on) return;
    if (i == 0) glds16(d.k, (unsigned)__builtin_amdgcn_readfirstlane(d.dk)); else if (i == 1) glds16(d.k + 64, (unsigned)__builtin_amdgcn_readfirstlane(d.dk + 8192));
    else if (i == 2) glds16(d.v, (unsigned)__builtin_amdgcn_readfirstlane(d.dv)); else glds16(d.v + 16 * 128, (unsigned)__builtin_amdgcn_readfirstlane(d.dv + 1024));
}
template <bool SLOW>
__device__ __forceinline__ void stepX(u32x4 (&pw)[4], f32x16& p1, float& l, f32x16& negm, const bf16x8 (&qr)[4], LAS const unsigned char* ka, LAS const unsigned char* kb, int kv0, int qpos, int hi, const bool first, LAS const unsigned char* vb, s16x4 (&vlo)[4], s16x4 (&vhh)[4], const DmaT& dma) {
    f32x16 p0;
    if (SLOW && first) {
#pragma unroll
        for (int r = 0; r < 16; ++r) negm[r] = 0.f;
    }
    bf16x8 kf[8];
#pragma unroll
    for (int d0 = 0; d0 < 4; ++d0) { LAS const unsigned char* kp = ((d0 & 1) ? kb : ka) + (d0 >> 1) * 512; kf[d0] = *(LAS const bf16x8*)(kp); }
#pragma unroll
    for (int d0 = 0; d0 < 4; ++d0) { LAS const unsigned char* kp = ((d0 & 1) ? kb : ka) + (d0 >> 1) * 512; kf[4 + d0] = *(LAS const bf16x8*)(kp + 4096); }
    __builtin_amdgcn_s_setprio(2);
    p0 = ATT_MFMA(kf[0], qr[0], negm);
#pragma unroll
    for (int d0 = 1; d0 < 4; ++d0) p0 = ATT_MFMA(kf[d0], qr[d0], p0);
    if (!SLOW) __builtin_amdgcn_sched_barrier(0);
    if (SLOW) {
        p1 = ATT_MFMA(kf[4], qr[0], negm);
#pragma unroll
        for (int d0 = 1; d0 < 4; ++d0) p1 = ATT_MFMA(kf[4 + d0], qr[d0], p1);
        __builtin_amdgcn_s_setprio(0);
        __builtin_amdgcn_sched_barrier(0);
    }
    if (SLOW) {
        int dq = qpos - kv0 - 4 * hi; asm volatile("" : "+v"(dq));
#pragma unroll
        for (int r = 0; r < 16; ++r) { const int cr = (r & 3) + 8 * (r >> 2); p0[r] = (cr > dq) ? -INFINITY : p0[r]; p1[r] = (cr + 32 > dq) ? -INFINITY : p1[r]; }
    }
    if (SLOW && first) {
        float rm = fmaxf(p0[0], p1[0]);
#pragma unroll
        for (int r = 1; r < 16; ++r) rm = fmaxf(rm, fmaxf(p0[r], p1[r]));
        rm = fmaxf(rm, __shfl_xor(rm, 32));
#pragma unroll
        for (int r = 0; r < 16; ++r) { p0[r] -= rm; p1[r] -= rm; negm[r] = -rm; }
    }
    float sa = 0.f, sb = 0.f;
    if (!SLOW) {
#pragma unroll
        for (int g = 0; g < 4; ++g) {
            p1 = (g == 0) ? ATT_MFMA(kf[4], qr[0], negm) : ATT_MFMA(kf[4 + g], qr[g], p1);
#pragma unroll
            for (int r = 4 * g; r < 4 * g + 4; r += 2) { p0[r] = __builtin_amdgcn_exp2f(p0[r]); p0[r + 1] = __builtin_amdgcn_exp2f(p0[r + 1]); sa = fadd_s(sa, p0[r]); sb = fadd_s(sb, p0[r + 1]); }
            if (g & 1) { const int w = g >> 1;
#pragma unroll
                for (int k = 0; k < 4; ++k) pw[w][k] = cvtpk_s(p0[8 * w + 2 * k], p0[8 * w + 2 * k + 1]); }
            dma_piece(dma, g);
            __builtin_amdgcn_sched_barrier(0);
        }
        l += sa + sb;
        __builtin_amdgcn_s_setprio(0);
    } else {
#pragma unroll
        for (int r = 0; r < 16; r += 2) { p0[r] = __builtin_amdgcn_exp2f(p0[r]); p0[r + 1] = __builtin_amdgcn_exp2f(p0[r + 1]); sa = fadd_s(sa, p0[r]); sb = fadd_s(sb, p0[r + 1]); }
        l += sa + sb;
#pragma unroll
        for (int k = 0; k < 4; ++k) { pw[0][k] = cvtpk_s(p0[2 * k], p0[2 * k + 1]); pw[1][k] = cvtpk_s(p0[8 + 2 * k], p0[8 + 2 * k + 1]); }
    }
#pragma unroll
    for (int j = 0; j < 4; ++j) { vlo[j] = vtr(vb + j * 4096); vhh[j] = vtr(vb + j * 4096 + 512); }
}
__device__ __forceinline__ void stepY(f32x16 (&o)[4], u32x4 (&pw)[4], f32x16& p1, float& l, LAS const unsigned char* vb, const s16x4 (&vlo)[4], const s16x4 (&vhh)[4], const DmaT& dma) {
    __builtin_amdgcn_sched_barrier(0);
    s16x4 lo[16], hh[16];
#define ATT_VRD(j) do { lo[j] = vtr(vb + ((j) & 3) * 4096 + ((j) >> 2) * 1024); hh[j] = vtr(vb + ((j) & 3) * 4096 + ((j) >> 2) * 1024 + 512); } while (0)
#pragma unroll
    for (int j = 0; j < 4; ++j) { lo[j] = vlo[j]; hh[j] = vhh[j]; }
    float sa = 0.f, sb = 0.f;
#pragma unroll
    for (int j = 0; j < 16; ++j) {
        if (j + 4 < 16) ATT_VRD(j + 4);
        { const bf16x8 vf = (bf16x8){lo[j][0], lo[j][1], lo[j][2], lo[j][3], hh[j][0], hh[j][1], hh[j][2], hh[j][3]};
          o[j & 3] = ATT_MFMA(__builtin_bit_cast(bf16x8, pw[j >> 2]), vf, o[j & 3]); }
        if (j < 8) { p1[2 * j] = __builtin_amdgcn_exp2f(p1[2 * j]); p1[2 * j + 1] = __builtin_amdgcn_exp2f(p1[2 * j + 1]); sa = fadd_s(sa, p1[2 * j]); sb = fadd_s(sb, p1[2 * j + 1]); }
        if (j == 3 || j == 7) { const int w = j >> 2;
#pragma unroll
            for (int k = 0; k < 4; ++k) pw[2 + w][k] = cvtpk_s(p1[8 * w + 2 * k], p1[8 * w + 2 * k + 1]); }
        if (j >= 8 && (j & 1) == 0) dma_piece(dma, (j - 8) >> 1);
        __builtin_amdgcn_sched_barrier(0);
    }
#undef ATT_VRD
    l += sa + sb;
}

struct Params { const bf16_t* Q; const bf16_t* K; const bf16_t* V; bf16_t* O; const float* g; float lam, oscale; };

template <int GRP>
__device__ __forceinline__ void run_tiles(f32x16 (&o)[4], float& l, const bf16x8 (&qr)[4], LAS unsigned char* lds, const unsigned ldsbase, const bf16_t* ksrc, const bf16_t* vsrc, int wid, int NT, int qa, int qpos, int hi, int kA, int kB, int voff) {
#define ATT_DMA(t, sboff) do { const unsigned sb_ = ldsbase + (unsigned)(sboff); const size_t go_ = (size_t)(t) * 64 * 128; \
        glds16(ksrc + go_, (unsigned)__builtin_amdgcn_readfirstlane(sb_ + wid * 1024)); \
        glds16(ksrc + go_ + 64, (unsigned)__builtin_amdgcn_readfirstlane(sb_ + 8192 + wid * 1024)); \
        glds16(vsrc + go_, (unsigned)__builtin_amdgcn_readfirstlane(sb_ + 16384 + (wid >> 1) * 4096 + (wid & 1) * 2048)); \
        glds16(vsrc + go_ + 16 * 128, (unsigned)__builtin_amdgcn_readfirstlane(sb_ + 16384 + (wid >> 1) * 4096 + (wid & 1) * 2048 + 1024)); } while (0)
#define END_EVEN() asm volatile("s_waitcnt lgkmcnt(0)\n\ts_barrier" ::: "memory")
#define END_ODD4() asm volatile("s_waitcnt vmcnt(4) lgkmcnt(0)\n\ts_barrier" ::: "memory")
#define END_ODD8() asm volatile("s_waitcnt vmcnt(8) lgkmcnt(0)\n\ts_barrier" ::: "memory")
#define END_ODDN(nn) do { if ((nn) >= 2) END_ODD8(); else if ((nn) == 1) END_ODD4(); else END_ODD0(); } while (0)
#define END_ODD0() asm volatile("s_waitcnt vmcnt(0) lgkmcnt(0)\n\ts_barrier" ::: "memory")
#define NXT(s) (((s) == (NSTAGE - 1) * STAGE) ? 0 : (s) + STAGE)
    u32x4 pw[4]; f32x16 negm, p1k; s16x4 vlo[4], vhh[4]; DmaT dma_off; dma_off.k = ksrc; dma_off.v = vsrc; dma_off.dk = 0u; dma_off.dv = 0u; dma_off.on = false;
#pragma unroll
    for (int j = 0; j < 4; ++j) { vlo[j] = (s16x4){0, 0, 0, 0}; vhh[j] = (s16x4){0, 0, 0, 0}; }
#pragma unroll
    for (int r = 0; r < 16; ++r) p1k[r] = 0.f;
#pragma unroll
    for (int k = 0; k < 4; ++k) pw[k] = (u32x4){0u, 0u, 0u, 0u};
#define SLOW_X(t, sc) do { const int kv0_ = 64 * (t); if (kv0_ <= qa + 31) stepX<true>(pw, p1k, l, negm, qr, lds + (sc) + kA, lds + (sc) + kB, kv0_, qpos, hi, (t) == 0, lds + (sc) + voff, vlo, vhh, dma_off); } while (0)
#define SLOW_Y(t, sc) do { if (64 * (t) <= qa + 31) stepY(o, pw, p1k, l, lds + (sc) + voff, vlo, vhh, dma_off); } while (0)
    int sc = 0;
    if (GRP == 1) END_EVEN();
#define TILE_SLOW(t) do { const int s3_ = (sc == 0) ? (NSTAGE - 1) * STAGE : sc - STAGE; const bool iss_ = ((t) + 3 < NT); const int newer_ = ((t) + 3 < NT ? 1 : 0) + ((t) + 2 < NT ? 1 : 0); \
        if (GRP == 0) { SLOW_X(t, sc); END_EVEN(); if (iss_) ATT_DMA((t) + 3, s3_); SLOW_Y(t, sc); END_ODDN(newer_); } \
        else          { if (iss_) ATT_DMA((t) + 3, s3_); SLOW_X(t, sc); END_ODDN(newer_); SLOW_Y(t, sc); END_EVEN(); } \
        sc = NXT(sc); } while (0)
    TILE_SLOW(0);
    int t = 1;
    for (; t < NT - 3; ++t) {
        const int s3 = (sc == 0) ? (NSTAGE - 1) * STAGE : sc - STAGE;
        DmaT dma; { const size_t go_ = (size_t)(t + 3) * 64 * 128; dma.k = ksrc + go_; dma.v = vsrc + go_; dma.dk = ldsbase + (unsigned)s3 + wid * 1024; dma.dv = ldsbase + (unsigned)s3 + 16384 + (wid >> 1) * 4096 + (wid & 1) * 2048; dma.on = true; }
        if (GRP == 0) { stepX<false>(pw, p1k, l, negm, qr, lds + sc + kA, lds + sc + kB, 64 * t, qpos, hi, false, lds + sc + voff, vlo, vhh, dma_off); END_EVEN(); stepY(o, pw, p1k, l, lds + sc + voff, vlo, vhh, dma); END_ODD8(); }
        else          { stepX<false>(pw, p1k, l, negm, qr, lds + sc + kA, lds + sc + kB, 64 * t, qpos, hi, false, lds + sc + voff, vlo, vhh, dma); END_ODD8(); stepY(o, pw, p1k, l, lds + sc + voff, vlo, vhh, dma_off); END_EVEN(); }
        sc = NXT(sc);
    }
    for (; t < NT; ++t) TILE_SLOW(t);
#undef TILE_SLOW
    if (GRP == 0) END_EVEN();
#undef SLOW_X
#undef SLOW_Y
}

__device__ __forceinline__ void unit(int b, int h, int qb, const Params& P, LAS unsigned char* lds, const int tid) {
    const int lane = tid & 63, r32 = lane & 31, hi = lane >> 5; const int wid = __builtin_amdgcn_readfirstlane(tid >> 6);
    const int rg = wid >> 1, mp = wid & 1;
    const size_t rowbase = (size_t)b * SEQ; const int q0 = qb * 128, NT = 2 * qb + 2, qa = q0 + 32 * rg, qpos = qa + r32;
    const unsigned ldsbase = (unsigned)(uintptr_t)lds;
    const size_t hbase = (size_t)(b * 8 + h) * SEQ;
    const bf16_t* ksrc = P.K + (hbase + 8 * wid + (lane & 7)) * 128 + (((lane >> 3) ^ (wid & 3)) * 8);
    const bf16_t* vsrc = P.V + (hbase + 32 * (wid & 1) + (lane >> 2)) * 128 + (wid >> 1) * 32 + (lane & 3) * 8;
#define ATT_WAITBAR() asm volatile("s_waitcnt vmcnt(0) lgkmcnt(0)\n\ts_barrier" ::: "memory")
    ATT_DMA(0, 0); ATT_DMA(1, STAGE); if (NT > 2) ATT_DMA(2, 2 * STAGE);
    bf16x8 qr[4];
    { const bf16_t* Qp = P.Q + (rowbase + qpos) * 2048 + h * 128 + mp * 64 + 8 * hi;
#pragma unroll
      for (int d0 = 0; d0 < 4; ++d0) qr[d0] = *(const bf16x8*)(Qp + 16 * d0); }
    f32x16 o[4];
#pragma unroll
    for (int d = 0; d < 4; ++d)
#pragma unroll
        for (int r = 0; r < 16; ++r) o[d][r] = 0.f;
    float l = 0.f;
    LAS float* wsf = (LAS float*)(lds + WSOFF) + wid * 64;
    const int kg = r32 >> 3, kbase0 = mp * 8192 + kg * 1024 + ((hi ^ (kg & 1)) * 128) + (r32 & 7) * 16;
    const int kA = kbase0 + 256 * (kg >> 1), kB = kbase0 + 256 * (1 - (kg >> 1));
    const int voff = 16384 + ((lane >> 4) & 1) * 32 + (lane & 3) * 8 + (4 * hi + ((lane & 15) >> 2)) * 64;
    ATT_WAITBAR();
    asm volatile("" :: "v"(qr[0]), "v"(qr[1]), "v"(qr[2]), "v"(qr[3]));
    if (wid < 4) run_tiles<0>(o, l, qr, lds, ldsbase, ksrc, vsrc, wid, NT, qa, qpos, hi, kA, kB, voff);
    else         run_tiles<1>(o, l, qr, lds, ldsbase, ksrc, vsrc, wid, NT, qa, qpos, hi, kA, kB, voff);
    int hi_e = hi, r32_e = r32; asm volatile("" : "+v"(hi_e), "+v"(r32_e));
    l += __shfl_xor(l, 32);
    const float inv = 1.0f / l;
    wsf[r32_e] = inv;
    LAS const float* wsr = wsf + 4 * hi_e;
#pragma unroll
    for (int r = 0; r < 16; ++r) { const float il = wsr[crow(r, 0)];
#pragma unroll
        for (int d = 0; d < 4; ++d) o[d][r] *= il; }
    LAS float* XB = (LAS float*)(lds + XOFF) + rg * XRG;
    LAS float* X = XB + (4 * hi_e) * 136 + r32_e;
    if (mp == 1) {
#pragma unroll
        for (int r = 0; r < 16; ++r)
#pragma unroll
            for (int d = 0; d < 4; ++d) X[crow(r, 0) * 136 + (d >> 1) * 68 + (d & 1) * 32] = o[d][r];
    }
    ATT_WAITBAR();
    if (mp == 0) {
#pragma unroll
        for (int r = 0; r < 16; ++r)
#pragma unroll
            for (int d = 0; d < 4; ++d) { LAS float* xp = X + crow(r, 0) * 136 + (d >> 1) * 68 + (d & 1) * 32; *xp = o[d][r] - P.lam * (*xp); }
        asm volatile("s_waitcnt lgkmcnt(0)" ::: "memory");
        int lane_e = r32_e + 32 * hi_e; const int row = lane_e >> 1, half = lane_e & 1;
        LAS const f32x4* rp = (LAS const f32x4*)(XB + row * 136 + half * 68);
        f32x4 v4[16]; float ss = 0.f;
#pragma unroll
        for (int k = 0; k < 16; ++k) { v4[k] = rp[k]; ss += (v4[k].x * v4[k].x + v4[k].y * v4[k].y) + (v4[k].z * v4[k].z + v4[k].w * v4[k].w); }
        ss += __shfl_xor(ss, 1);
        const float rs = __builtin_amdgcn_rsqf(ss * (1.0f / 128.0f) + LN_EPS) * P.oscale;
        bf16_t* op = P.O + (rowbase + qa + row) * 2048 + h * 128 + half * 64; const float* gp = P.g + half * 64;
#pragma unroll
        for (int k = 0; k < 8; ++k) { const f32x4 g0 = *(const f32x4*)(gp + 8 * k) * rs, g1 = *(const f32x4*)(gp + 8 * k + 4) * rs; const f32x4 a0 = v4[2 * k] * g0, a1 = v4[2 * k + 1] * g1;
            u32x4 w; w.x = cvt_pk_bf16(a0.x, a0.y); w.y = cvt_pk_bf16(a0.z, a0.w); w.z = cvt_pk_bf16(a1.x, a1.y); w.w = cvt_pk_bf16(a1.z, a1.w);
            *(u32x4*)(op + 8 * k) = w; }
    }
    ATT_WAITBAR();
#undef ATT_DMA
#undef END_EVEN
#undef END_ODD4
#undef END_ODD8
#undef END_ODDN
#undef END_ODD0
#undef NXT
}
}

struct Args { const float* in[16]; float* out; unsigned char* ws; float invf[32]; float lam_init[4]; int ph_lo, ph_hi, coop, pad; };

struct Ctx { int tid, lane, wave, gw, NGW; LAS unsigned char* lds; };

__device__ __forceinline__ void tr_item(const float* W, int ldw, int k0, int n0, bf16_t* dst, int pitch, int drow0, int dcol0, LAS float* scr, int lane) {
    float wv[32];
#pragma unroll
    for (int i = 0; i < 32; ++i) { const int kk = 2 * i + (lane >> 5); wv[i] = W[(size_t)(k0 + kk) * ldw + n0 + (lane & 31)]; }
#pragma unroll
    for (int i = 0; i < 32; ++i) { const int kk = 2 * i + (lane >> 5); scr[kk * 33 + (lane & 31)] = wv[i]; }
    asm volatile("s_waitcnt lgkmcnt(0)" ::: "memory");
    const int c = lane & 7;
#pragma unroll
    for (int j = 0; j < 4; ++j) { const int n = (lane >> 3) + 8 * j; const LAS float* s = scr + (8 * c) * 33 + n;
        u32x4 o; o.x = cvt_pk_bf16(s[0 * 33], s[1 * 33]); o.y = cvt_pk_bf16(s[2 * 33], s[3 * 33]); o.z = cvt_pk_bf16(s[4 * 33], s[5 * 33]); o.w = cvt_pk_bf16(s[6 * 33], s[7 * 33]);
        *(u32x4*)(dst + (size_t)(drow0 + n) * pitch + dcol0 + 8 * c) = o; }
    asm volatile("s_waitcnt lgkmcnt(0)" ::: "memory");
}
__device__ __forceinline__ void conv_ffn(const Ctx& C, const Args& a, int l, int f) {
    LAS float* scr = (LAS float*)(C.lds + C.wave * 8448);
    const size_t wo = (size_t)(l * 2 + f) * D * FF;
    const float* w1 = a.in[11] + wo; const float* w3 = a.in[12] + wo; const float* w2 = a.in[13] + wo;
    bf16_t* WUP = (bf16_t*)(a.ws + WS_WUP); bf16_t* W2 = (bf16_t*)(a.ws + WS_W2);
    for (int it = C.gw; it < 4224; it += C.NGW) {
        if (it < 2816) { const int r = it < 1408 ? it : it - 1408; const int kb = r / 88, nb = r % 88, n0 = 32 * nb;
            tr_item(it < 1408 ? w1 : w3, FF, 64 * kb, n0, WUP, D, (n0 >> 7) * 256 + (n0 & 127) + (it < 1408 ? 0 : 128), 64 * kb, scr, C.lane); }
        else { const int r = it - 2816, kb = r >> 5, nb = r & 31; tr_item(w2, D, 64 * kb, 32 * nb, W2, FF, 32 * nb, 64 * kb, scr, C.lane); }
    }
}
__device__ __forceinline__ void conv_mixer(const Ctx& C, const Args& a, int l) {
    LAS float* scr = (LAS float*)(C.lds + C.wave * 8448);
    const float* win = a.in[1] + (size_t)l * D * INW; const float* wbr = a.in[9] + (size_t)l * 2 * D * D; const float* wout = a.in[10] + (size_t)l * D * D;
    bf16_t* WIN = (bf16_t*)(a.ws + WS_WIN); bf16_t* WBR = (bf16_t*)(a.ws + WS_WBR); bf16_t* WOUT = (bf16_t*)(a.ws + WS_WOUT);
    for (int it = C.gw; it < 5120; it += C.NGW) {
        if (it < 3584) { const int kb = it / 224, nb = it % 224, n0 = 32 * nb; int dr = n0;
            if (n0 >= 2048 && n0 < 4096) { const int w = n0 & 255; dr = (n0 & ~255) + ((w >> 5) & 1) * 128 + (w >> 6) * 32; }
            tr_item(win, INW, 64 * kb, n0, WIN, D, dr, 64 * kb, scr, C.lane); }
        else if (it < 4608) { const int r = it - 3584, br = r >> 9, q = r & 511, kb = q >> 5, nb = q & 31; tr_item(wbr + (size_t)br * D * D, D, 64 * kb, 32 * nb, WBR, 2048, 32 * nb, br * 1024 + 64 * kb, scr, C.lane); }
        else { const int q = it - 4608, kb = q >> 5, nb = q & 31; tr_item(wout, D, 64 * kb, 32 * nb, WOUT, D, 32 * nb, 64 * kb, scr, C.lane); }
    }
    const float* sw = a.in[5] + (size_t)l * 8 * 128 * 128; bf16_t* SW = (bf16_t*)(a.ws + WS_SGUW);
    for (int i = C.gw * 64 + C.lane; i < 8 * 128 * 128 / 2; i += C.NGW * 64) { const int e = 2 * i, r = e & 127, t = (e >> 7) & 127;
        const f32x2 v = *(const f32x2*)(sw + e); *(unsigned*)(SW + e) = cvt_pk_bf16(r <= t ? v.x : 0.f, (r + 1) <= t ? v.y : 0.f); }
}
__device__ __forceinline__ void ln_rows(const Ctx& C, float* y, bf16_t* xb, const float* g, const float* b, f32x2* stats, const bool write_f32) {
    f32x4 gg[4], bb[4];
#pragma unroll
    for (int j = 0; j < 4; ++j) { gg[j] = ((const f32x4*)g)[C.lane + 64 * j]; bb[j] = ((const f32x4*)b)[C.lane + 64 * j]; }
    for (int m = C.gw; m < T; m += C.NGW) {
        f32x4* row = (f32x4*)(y + (size_t)m * D) + C.lane; f32x4 v[4]; float s = 0.f;
#pragma unroll
        for (int j = 0; j < 4; ++j) { v[j] = row[64 * j]; s += (v[j].x + v[j].y) + (v[j].z + v[j].w); }
        const float mean = wave_sum(s) * (1.f / D); float s2 = 0.f;
#pragma unroll
        for (int j = 0; j < 4; ++j) { v[j] = v[j] - mean; s2 += (v[j].x * v[j].x + v[j].y * v[j].y) + (v[j].z * v[j].z + v[j].w * v[j].w); }
        const float rstd = 1.f / sqrtf(wave_sum(s2) * (1.f / D) + LN_EPS);
        if (C.lane == 0) stats[m] = (f32x2){mean, rstd};
        u32x2* o8 = (u32x2*)(xb + (size_t)m * D) + C.lane;
#pragma unroll
        for (int j = 0; j < 4; ++j) { const f32x4 o = v[j] * rstd * gg[j] + bb[j]; if (write_f32) row[64 * j] = o; u32x2 w; w.x = cvt_pk_bf16(o.x, o.y); w.y = cvt_pk_bf16(o.z, o.w); o8[64 * j] = w; }
    }
}
__device__ __forceinline__ void prologue(const Ctx& C, const Args& a) {
    const float* x = a.in[0]; bf16_t* xb = (bf16_t*)(a.ws + WS_XB);
    for (int m = C.gw; m < T; m += C.NGW) { const f32x4* row = (const f32x4*)(x + (size_t)m * D) + C.lane; u32x2* o8 = (u32x2*)(xb + (size_t)m * D) + C.lane;
#pragma unroll
        for (int j = 0; j < 4; ++j) { const f32x4 v = row[64 * j]; u32x2 w; w.x = cvt_pk_bf16(v.x, v.y); w.y = cvt_pk_bf16(v.z, v.w); o8[64 * j] = w; } }
    float* rope = (float*)(a.ws + WS_ROPE);
    for (int i = C.gw * 64 + C.lane; i < SEQ * 32; i += C.NGW * 64) { const int pos = i >> 5, j = i & 31;
        const float ang = __fmul_rn((float)pos, a.invf[j]); const double ad = (double)ang;
        const double n = __builtin_rint(ad * 0.15915494309189535); const double r = (ad - n * 6.283185307179586) - n * 2.4492935982947064e-16; const double r2 = r * r;
        double sn = 1.0, cs = 1.0;
#pragma unroll
        for (int k = 13; k >= 1; --k) { sn = 1.0 - r2 * (1.0 / (double)((2 * k) * (2 * k + 1))) * sn; cs = 1.0 - r2 * (1.0 / (double)((2 * k - 1) * (2 * k))) * cs; }
        sn *= r;
        rope[(size_t)pos * 64 + j] = (float)cs; rope[(size_t)pos * 64 + 32 + j] = (float)sn; }
    conv_ffn(C, a, 0, 0);
}
__device__ __forceinline__ void sgu_chunk(const Ctx& C, const Args& a, int l, int n) {
    LAS unsigned char* lds = C.lds; LAS f32x2* stats = (LAS f32x2*)lds; LAS unsigned char* vimg = lds + 1024;
    const bf16_t* VB = (const bf16_t*)(a.ws + WS_V); bf16_t* HC = (bf16_t*)(a.ws + WS_HCAT); const bf16_t* SW = (const bf16_t*)(a.ws + WS_SGUW);
    const float* gam = a.in[3] + l * D; const float* bet = a.in[4] + l * D; const float* sb = a.in[6] + l * 1024;
    const size_t R0 = (size_t)n * 128; const int lane = C.lane, wid = C.wave, r32 = lane & 31, hi = lane >> 5;
    for (int rr = 0; rr < 16; ++rr) { const int r = wid * 16 + rr; const u32x4* p = (const u32x4*)(VB + (R0 + r) * D); const u32x4 a0 = p[lane], a1 = p[64 + lane];
        float s = 0.f, s2 = 0.f;
#pragma unroll
        for (int k = 0; k < 4; ++k) { const float x0 = bf_lo(a0[k]), x1 = bf_hi(a0[k]), x2 = bf_lo(a1[k]), x3 = bf_hi(a1[k]); s += (x0 + x1) + (x2 + x3); s2 += (x0 * x0 + x1 * x1) + (x2 * x2 + x3 * x3); }
        s = wave_sum(s); s2 = wave_sum(s2); const float mean = s * (1.f / D); const float var = fmaxf(s2 * (1.f / D) - mean * mean, 0.f);
        if (lane == 0) stats[r] = (f32x2){mean, 1.f / sqrtf(var + LN_EPS)}; }
    __syncthreads();
    const int tb = wid >> 1, ch = wid & 1;
    const int voff = ((lane >> 4) & 1) * 32 + (lane & 3) * 8 + (4 * hi + ((lane & 15) >> 2)) * 64;
    for (int g = 0; g < 8; ++g) {
#pragma unroll
        for (int j = 0; j < 4; ++j) { const int p = C.tid + 512 * j, r = p >> 4, c8 = (p & 15) * 8; const f32x2 st = stats[r];
            const u32x4 w = *(const u32x4*)(VB + (R0 + r) * D + g * 128 + c8); const f32x4 g0 = *(const f32x4*)(gam + g * 128 + c8), g1 = *(const f32x4*)(gam + g * 128 + c8 + 4);
            const f32x4 b0 = *(const f32x4*)(bet + g * 128 + c8), b1 = *(const f32x4*)(bet + g * 128 + c8 + 4);
            u32x4 o; o.x = cvt_pk_bf16((bf_lo(w.x) - st.x) * st.y * g0[0] + b0[0], (bf_hi(w.x) - st.x) * st.y * g0[1] + b0[1]);
            o.y = cvt_pk_bf16((bf_lo(w.y) - st.x) * st.y * g0[2] + b0[2], (bf_hi(w.y) - st.x) * st.y * g0[3] + b0[3]);
            o.z = cvt_pk_bf16((bf_lo(w.z) - st.x) * st.y * g1[0] + b1[0], (bf_hi(w.z) - st.x) * st.y * g1[1] + b1[1]);
            o.w = cvt_pk_bf16((bf_lo(w.w) - st.x) * st.y * g1[2] + b1[2], (bf_hi(w.w) - st.x) * st.y * g1[3] + b1[3]);
            *(LAS u32x4*)(vimg + (c8 >> 5) * 8192 + r * 64 + (c8 & 31) * 2) = o; }
        __syncthreads();
        f32x16 acc[2];
#pragma unroll
        for (int r = 0; r < 16; ++r) { acc[0][r] = 0.f; acc[1][r] = 0.f; }
        const bf16_t* wrow = SW + ((size_t)g * 128 + 32 * tb + r32) * 128 + 4 * hi;
#pragma unroll
        for (int kc = 0; kc < 8; ++kc) {
            const u32x2 alo = *(const u32x2*)(wrow + 16 * kc), ahi = *(const u32x2*)(wrow + 16 * kc + 8);
            const bf16x8 af = __builtin_bit_cast(bf16x8, (u32x4){alo.x, alo.y, ahi.x, ahi.y});
#pragma unroll
            for (int j = 0; j < 2; ++j) { LAS const unsigned char* vp = vimg + (2 * ch + j) * 8192 + kc * 1024 + voff; const s16x4 lo = att::vtr(vp), hh = att::vtr(vp + 512);
                const bf16x8 vf = (bf16x8){lo[0], lo[1], lo[2], lo[3], hh[0], hh[1], hh[2], hh[3]}; acc[j] = ATT_MFMA(af, vf, acc[j]); }
        }
        int hi_e = hi, r32_e = r32; asm volatile("" : "+v"(hi_e), "+v"(r32_e));
        const float* sbp = sb + g * 128 + 32 * tb + 4 * hi_e; bf16_t* hp = HC + (R0 + 32 * tb + 4 * hi_e) * 2048 + g * 128 + 64 * ch + r32_e;
        bf16_t uu[16][2]; float bsv[16];
#pragma unroll
        for (int r = 0; r < 16; ++r) { bsv[r] = sbp[att::crow(r, 0)];
#pragma unroll
            for (int j = 0; j < 2; ++j) uu[r][j] = hp[att::crow(r, 0) * 2048 + 32 * j]; }
        asm volatile("" ::: "memory");
#pragma unroll
        for (int r = 0; r < 16; ++r)
#pragma unroll
            for (int j = 0; j < 2; ++j) { const float u = __uint_as_float((unsigned)uu[r][j] << 16);
                hp[att::crow(r, 0) * 2048 + 32 * j] = (bf16_t)(cvt_pk_bf16(u * (acc[j][r] + bsv[r]), 0.f) & 0xffffu); }
        __syncthreads();
    }
}


#define XB_TMO      128
#define XB_XCNT(j)  (256  + 64 * (j))
#define XB_XSUB(j)  (1280 + 64 * (j))
#define XB_XGEN(j)  (2304 + 64 * (j))
#define XB_TOP      3328
#define XB_TOPGEN   3392
#define XCD_BAR_WORDS 3456
#define XB_SPIN_CAP (1u << 22)
__device__ __forceinline__ unsigned xb_ld(unsigned* p)              { return __hip_atomic_load(p, __ATOMIC_RELAXED, __HIP_MEMORY_SCOPE_AGENT); }
__device__ __forceinline__ unsigned xb_add(unsigned* p, unsigned v) { return __hip_atomic_fetch_add(p, v, __ATOMIC_RELAXED, __HIP_MEMORY_SCOPE_AGENT); }
__device__ __forceinline__ unsigned xb_xcc_id() { return (unsigned)__builtin_amdgcn_s_getreg((3 << 11) | 20) & 0xFu; }
#define XB_SPIN(cond, bar) do { unsigned _sp = 0; while (cond) { __builtin_amdgcn_s_sleep(1); \
    if ((++_sp & 255u) == 0u) { if (xb_ld(&(bar)[XB_TMO])) break; if (_sp > XB_SPIN_CAP) { atomicAdd(&(bar)[XB_TMO], 1u); break; } } } } while (0)
struct XcdBarrier { unsigned* bar; unsigned x; volatile LAS unsigned* st; };
__device__ __forceinline__ XcdBarrier xcd_barrier_post(unsigned* bar, volatile LAS unsigned* st) {
    XcdBarrier b; b.bar = bar; b.x = xb_xcc_id(); b.st = st;
    if (threadIdx.x == 0) (void)xb_add(&bar[XB_XCNT(b.x)], 1u);
    return b;
}
__device__ __forceinline__ void xcd_barrier_complete(unsigned* bar, unsigned x, unsigned& nloc, unsigned& nx) {
    const unsigned G = gridDim.x * gridDim.y * gridDim.z;
    unsigned sum, cnt, mine, sp = 0u;
    for (;;) {
        sum = 0u; cnt = 0u; mine = 0u;
#pragma unroll
        for (unsigned j = 0; j < 16; ++j) { const unsigned c = xb_ld(&bar[XB_XCNT(j)]); sum += c; cnt += (c > 0u) ? 1u : 0u; mine = (j == x) ? c : mine; }
        if (sum == G) break;
        __builtin_amdgcn_s_sleep(1);
        if ((++sp & 255u) == 0u) { if (xb_ld(&bar[XB_TMO])) break; if (sp > XB_SPIN_CAP) { atomicAdd(&bar[XB_TMO], 1u); break; } }
    }
    nloc = mine > 0u ? mine : 1u; nx = cnt > 0u ? cnt : 1u;
}
__device__ __forceinline__ void xcd_barrier(const XcdBarrier& b) {
    asm volatile("s_waitcnt vmcnt(0)" ::: "memory");
    __syncthreads();
    if (threadIdx.x == 0) {
        unsigned* bar = b.bar;
        __builtin_amdgcn_s_waitcnt(0);
        unsigned nloc = b.st[0], nx = b.st[1];
        if (nloc == 0u) { xcd_barrier_complete(bar, b.x, nloc, nx); b.st[0] = nloc; b.st[1] = nx; }
        const unsigned old = xb_add(&bar[XB_XSUB(b.x)], 1u);
        const unsigned gen = old / nloc;
        if (old + 1u == (gen + 1u) * nloc) {
            __builtin_amdgcn_fence(__ATOMIC_RELEASE, "agent");
            asm volatile("s_waitcnt vmcnt(0)" ::: "memory");
            const unsigned og = xb_add(&bar[XB_TOP], 1u);
            const unsigned tg = og / nx;
            if (og + 1u == (tg + 1u) * nx) xb_add(&bar[XB_TOPGEN], 1u);
            else XB_SPIN(xb_ld(&bar[XB_TOPGEN]) == tg, bar);
            __builtin_amdgcn_fence(__ATOMIC_ACQUIRE, "agent");
            xb_add(&bar[XB_XGEN(b.x)], 1u);
            asm volatile("s_waitcnt vmcnt(0)" ::: "memory");
        } else {
            XB_SPIN(xb_ld(&bar[XB_XGEN(b.x)]) == gen, bar);
            __builtin_amdgcn_fence(__ATOMIC_ACQUIRE, "agent");
            asm volatile("s_waitcnt vmcnt(0)" ::: "memory");
        }
    }
    __syncthreads();
}

__global__ void __launch_bounds__(512, 2) mk_fwd(Args a) {
    extern __shared__ __attribute__((aligned(16))) unsigned char lds_raw[];
    volatile LAS unsigned* bst = (volatile LAS unsigned*)((LAS unsigned char*)lds_raw + 134144);
    if (threadIdx.x < 2) bst[threadIdx.x] = 0u;
    __syncthreads();
    XcdBarrier gbar; gbar.bar = (unsigned*)a.ws; gbar.x = 0; gbar.st = bst;
    if (a.coop) gbar = xcd_barrier_post((unsigned*)a.ws, bst);
    const int G = gridDim.x, bx = blockIdx.x; const int vcu = (G % 8 == 0) ? (bx % 8) * (G / 8) + bx / 8 : bx;
    unsigned char* ws = a.ws;
    bf16_t* XB = (bf16_t*)(ws + WS_XB);
    for (int ph = a.ph_lo; ph < a.ph_hi; ++ph) {
        int tid_ = threadIdx.x; asm volatile("" : "+v"(tid_));
        Ctx C; C.lds = (LAS unsigned char*)lds_raw; C.tid = tid_; C.lane = C.tid & 63; C.wave = __builtin_amdgcn_readfirstlane(C.tid >> 6);
        C.gw = vcu * 8 + C.wave; C.NGW = G * 8;
        if (ph == 0) prologue(C, a);
        else {
            const int l = (ph - 1) / 11, s = (ph - 1) % 11;
            if (s == 0 || s == 8) {
                pg8::Gemm g{XB, (const bf16_t*)(ws + WS_WUP), T, 2 * FF, D}; pg8::StaticOrder S; S.init(T, 2 * FF, G, bx);
                pg8::EpiSwiGLU E{(bf16_t*)(ws + WS_ACT)};
                pg8::gemm_phase<pg8::EpiSwiGLU>(C.lds, g, S, E, C.tid);
            } else if (s == 1 || s == 9) {
                pg8::Gemm g{(const bf16_t*)(ws + WS_ACT), (const bf16_t*)(ws + WS_W2), T, D, FF}; pg8::StaticOrder S; S.init(T, D, G, bx);
                const bool raw = (l == 0 && s == 1); const int pli = (s == 1) ? l * 3 - 1 : l * 3 + 1;
                pg8::EpiResid E{raw ? a.in[0] : a.out, a.out, 0.5f, raw ? nullptr : (const f32x2*)(ws + WS_STATS), a.in[14] + (raw ? 0 : pli) * D, a.in[15] + (raw ? 0 : pli) * D};
                pg8::gemm_phase<pg8::EpiResid>(C.lds, g, S, E, C.tid);
            } else if (s == 2 || s == 7 || s == 10) {
                const int li = (s == 2) ? 0 : (s == 7) ? 1 : 2;
                ln_rows(C, a.out, XB, a.in[14] + (l * 3 + li) * D, a.in[15] + (l * 3 + li) * D, (f32x2*)(ws + WS_STATS), l == DEPTH - 1 && s == 10);
                if (s == 2) conv_mixer(C, a, l); else if (s == 7) conv_ffn(C, a, l, 1); else if (l + 1 < DEPTH) conv_ffn(C, a, l + 1, 0);
            } else if (s == 3) {
                pg8::Gemm g{XB, (const bf16_t*)(ws + WS_WIN), T, INW, D}; pg8::StaticOrder S; S.init(T, INW, G, bx);
                pg8::EpiInProj E{(bf16_t*)(ws + WS_HCAT), (bf16_t*)(ws + WS_V), (bf16_t*)(ws + WS_K), (bf16_t*)(ws + WS_VAL), (bf16_t*)(ws + WS_GA), (bf16_t*)(ws + WS_GB), a.in[2] + l * 2 * D, (const float*)(ws + WS_ROPE)};
                pg8::gemm_phase<pg8::EpiInProj>(C.lds, g, S, E, C.tid);
            } else if (s == 4) {
                const float* lf = a.in[7] + l * 256;
                const float s1 = wave_sum(lf[C.lane] * lf[64 + C.lane]), s2 = wave_sum(lf[128 + C.lane] * lf[192 + C.lane]);
                const float li = a.lam_init[l];
                att::Params P{(const bf16_t*)(ws + WS_HCAT) + 1024, (const bf16_t*)(ws + WS_K), (const bf16_t*)(ws + WS_VAL), (bf16_t*)(ws + WS_HCAT) + 1024, a.in[8] + l * 128, expf(s1) - expf(s2) + li, 1.0f - li};
                const int niter = (G == 256) ? 8 : (2048 + G - 1) / G;
                for (int i = 0; i < niter; ++i) {
                    int bh, qb;
                    if (G == 256) { const int base = 32 * ((i >> 1) & 1) + (vcu & 31); bh = 2 * (vcu >> 5) + (i >> 2); qb = (i & 1) ? base : 127 - base; }
                    else { const int u = bx + i * G; if (u >= 2048) break; bh = u >> 7; qb = 127 - (u & 127); }
                    att::unit(bh >> 3, bh & 7, qb, P, C.lds, C.tid);
                }
                for (int n = bx; n < 256; n += G) sgu_chunk(C, a, l, n);
            } else if (s == 5) {
                pg8::Gemm g{(const bf16_t*)(ws + WS_HCAT), (const bf16_t*)(ws + WS_WBR), T, D, 2 * D}; pg8::StaticOrder S; S.init(T, D, G, bx);
                pg8::EpiMerge E{(const bf16_t*)(ws + WS_GA), (const bf16_t*)(ws + WS_GB), (bf16_t*)(ws + WS_V)};
                pg8::gemm_phase<pg8::EpiMerge>(C.lds, g, S, E, C.tid);
            } else {
                pg8::Gemm g{(const bf16_t*)(ws + WS_V), (const bf16_t*)(ws + WS_WOUT), T, D, D}; pg8::StaticOrder S; S.init(T, D, G, bx);
                pg8::EpiResid E{a.out, a.out, 1.0f, (const f32x2*)(ws + WS_STATS), a.in[14] + (l * 3) * D, a.in[15] + (l * 3) * D};
                pg8::gemm_phase<pg8::EpiResid>(C.lds, g, S, E, C.tid);
            }
        }
        if (ph + 1 < a.ph_hi) { if (a.coop) { if (ph == a.ph_lo) cg::this_grid().sync(); else xcd_barrier(gbar); } }
    }
}

constexpr int LDS_BYTES = 135168;

extern "C" void kernel_launch(void* const* d_in, const int* in_sizes, int n_in, void* d_out, int out_size, void* d_ws, size_t ws_size, hipStream_t stream) {
    static int grid = 0;
    if (grid == 0) {
        if (n_in != 16 || out_size != T * D || ws_size < WS_END) { fprintf(stderr, "kernel_launch: unexpected shapes (n_in %d out %d ws %zu need %zu)\n", n_in, out_size, ws_size, (size_t)WS_END); grid = -1; return; }
        int dev = 0, cus = 0, per_cu = 0;
        hipGetDevice(&dev); hipDeviceGetAttribute(&cus, hipDeviceAttributeMultiprocessorCount, dev);
        if (hipFuncSetAttribute((const void*)mk_fwd, hipFuncAttributeMaxDynamicSharedMemorySize, LDS_BYTES) != hipSuccess) { fprintf(stderr, "kernel_launch: hipFuncSetAttribute failed\n"); grid = -1; return; }
        if (hipOccupancyMaxActiveBlocksPerMultiprocessor(&per_cu, (const void*)mk_fwd, 512, LDS_BYTES) != hipSuccess || per_cu < 1) per_cu = 1;
        (void)hipGetLastError();
        grid = cus * per_cu;
    }
    if (grid < 0) return;
    (void)hipMemsetAsync(d_ws, 0, 16384, stream);
    Args a{};
    for (int i = 0; i < 16; ++i) a.in[i] = (const float*)d_in[i];
    a.out = (float*)d_out; a.ws = (unsigned char*)d_ws;
    for (int j = 0; j < 32; ++j) a.invf[j] = (float)pow(10000.0, -(double)j / 32.0);
    for (int l = 0; l < DEPTH; ++l) a.lam_init[l] = (float)(0.8 - 0.6 * exp(-0.3 * (double)l));
#if MK_COOP
    a.ph_lo = 0; a.ph_hi = NPH; a.coop = 1;
    void* args[] = {&a};
    hipError_t e = hipLaunchCooperativeKernel((const void*)mk_fwd, dim3(grid), dim3(512), args, LDS_BYTES, stream);
    if (e != hipSuccess) fprintf(stderr, "cooperative launch failed: %s (grid %d)\n", hipGetErrorString(e), grid);
#else
    a.coop = 0;
    for (int ph = 0; ph < NPH; ++ph) { a.ph_lo = ph; a.ph_hi = ph + 1; hipLaunchKernelGGL(mk_fwd, dim3(grid), dim3(512), LDS_BYTES, stream, a); }
#endif
}
```

```cpp
#include <hip/hip_runtime.h>
#include <hip/hip_cooperative_groups.h>
#include <cstdio>
#include <cstdint>
#include <cmath>
namespace cg = cooperative_groups;

#ifndef MK_COOP
#define MK_COOP 1
#endif

#define LAS __attribute__((address_space(3)))
typedef unsigned short bf16_t;
typedef short bf16x8 __attribute__((ext_vector_type(8)));
typedef short s16x4 __attribute__((ext_vector_type(4)));
typedef float f32x2 __attribute__((ext_vector_type(2)));
typedef float f32x4 __attribute__((ext_vector_type(4)));
typedef float f32x16 __attribute__((ext_vector_type(16)));
typedef unsigned u32x2 __attribute__((ext_vector_type(2)));
typedef unsigned u32x4 __attribute__((ext_vector_type(4)));

constexpr int SEQ = 16384, NB = 2, T = NB * SEQ, D = 1024, FF = 2816, INW = 7168, DEPTH = 4;
constexpr float LN_EPS = 1e-5f;
constexpr float ALPHA = 1.681792830507429f;
constexpr float C2 = 0.125f * 1.4426950408889634f;
constexpr int NPH = 1 + 11 * DEPTH;

constexpr size_t MiB = 1u << 20;
constexpr size_t WS_STATS = 64 * 1024;
constexpr size_t WS_ROPE = 1 * MiB;
constexpr size_t WS_SGUW = 5 * MiB;
constexpr size_t WS_XB = 8 * MiB;
constexpr size_t WS_WIN = 72 * MiB, WS_WBR = 86 * MiB, WS_WOUT = 90 * MiB;
constexpr size_t WS_BIG = 92 * MiB;
constexpr size_t WS_HCAT = WS_BIG;
constexpr size_t WS_V = WS_BIG + 128 * MiB;
constexpr size_t WS_K = WS_BIG + 192 * MiB;
constexpr size_t WS_VAL = WS_BIG + 256 * MiB;
constexpr size_t WS_GA = WS_BIG + 320 * MiB;
constexpr size_t WS_GB = WS_BIG + 384 * MiB;
constexpr size_t WS_ACT = WS_BIG;
constexpr size_t WS_WUP = WS_BIG + 320 * MiB;
constexpr size_t WS_W2 = WS_BIG + 332 * MiB;
constexpr size_t WS_END = WS_BIG + 448 * MiB;

typedef __bf16 bf16x2_t __attribute__((ext_vector_type(2)));
__device__ __forceinline__ unsigned cvt_pk_bf16(float lo, float hi) { f32x2 v = {lo, hi}; bf16x2_t b = __builtin_convertvector(v, bf16x2_t); return __builtin_bit_cast(unsigned, b); }
__device__ __forceinline__ unsigned cvtpk_s(float lo, float hi) { return cvt_pk_bf16(lo, hi); }
__device__ __forceinline__ float bf_lo(unsigned w) { return __uint_as_float(w << 16); }
__device__ __forceinline__ float bf_hi(unsigned w) { return __uint_as_float(w & 0xffff0000u); }
__device__ __forceinline__ float wave_sum(float v) {
#pragma unroll
    for (int o = 1; o < 64; o <<= 1) v += __shfl_xor(v, o);
    return v;
}
__device__ __forceinline__ f32x2 gelu_pk(f32x2 v) {
    const f32x2 av = __builtin_elementwise_abs(v), d = av * 0.2316418882f + 1.0f;
    f32x2 t; t.x = __builtin_amdgcn_rcpf(d.x); t.y = __builtin_amdgcn_rcpf(d.y);
    f32x2 q = t * 0.5307027145f + (-0.7265760135f); q = q * t + 0.7107068705f; q = q * t + (-0.142248368f); q = q * t + 0.127414796f; q = q * t;
    const f32x2 s = (v * v) * (-0.72134752044f);
    f32x2 e; e.x = __builtin_amdgcn_exp2f(s.x); e.y = __builtin_amdgcn_exp2f(s.y);
    const f32x2 m = v * (q * e), r = v - m;
    f32x2 o; o.x = v.x < 0.f ? m.x : r.x; o.y = v.y < 0.f ? m.y : r.y; return o;
}
__device__ __forceinline__ float sigmoidf_(float x) { return __builtin_amdgcn_rcpf(1.0f + __builtin_amdgcn_exp2f(-1.4426950408889634f * x)); }

namespace pg8 {
constexpr int BM = 256, BK = 64, HALF = 128, HTB = HALF * BK * 2, STAGE_BYTES = 8 * HTB, NXCD = 8, WGM = 4;
__host__ __device__ __forceinline__ int lds_byte(int r, int c) { const int st = (r >> 4) * 2 + (c >> 5), rr = r & 15, cc = c & 31, ob = rr * 64 + cc * 2; return st * 1024 + (ob ^ (((ob >> 9) & 1) << 5)); }
__host__ __device__ __forceinline__ void stage_rc(int b, int& R, int& C) { const int st = b / 1024, sb = b % 1024, swz = sb ^ (((sb >> 9) & 1) << 5); R = (st >> 1) * 16 + swz / 64; C = (st & 1) * 32 + (swz % 64) / 2; }
__host__ __device__ __forceinline__ int perm32(int rho) { const int n = rho >> 4, i = rho & 15; return 8 * (i >> 2) + 4 * n + (i & 3); }
struct Unit { int pm, pn; };
struct Gemm { const bf16_t* A; const bf16_t* Bt; int M, N, K; };
struct StaticOrder {
    int nM, nN, nwg, G, c;
    __host__ __device__ void init(int M, int N, int G_, int c_) { nM = M / BM; nN = N / BM; nwg = nM * nN; G = G_; c = c_; }
    __host__ __device__ bool next(int i, Unit& u) const {
        const long L = (long)i * G + c; if (L >= nwg) return false;
        int wgid = (int)L; { const int q = nwg / NXCD, r = nwg % NXCD, xcd = wgid % NXCD, off = wgid / NXCD; wgid = (xcd < r ? xcd * (q + 1) : r * (q + 1) + (xcd - r) * q) + off; }
        const int nig = WGM * nN, gid = wgid / nig, fm = gid * WGM, gsz = (nM - fm) < WGM ? (nM - fm) : WGM;
        u.pm = fm + ((wgid % nig) % gsz); u.pn = (wgid % nig) / gsz; return true;
    }
};
typedef f32x4 Acc[2][2][4][2];

template <class Epi, bool SP2 = true, bool ALIGN_EPI = true>
__device__ __forceinline__ void gemm_phase(LAS unsigned char* lds, const Gemm g, const StaticOrder& S, const Epi& E, const int tid) {
    const int wid = __builtin_amdgcn_readfirstlane(tid >> 6), lane = tid & 63, wr = wid >> 2, wc = wid & 3, fr = lane & 15, fq = lane >> 4;
    const int K = g.K, nt = K / BK;
    unsigned voffA[2], voffB[2];
#pragma unroll
    for (int i = 0; i < 2; ++i) { int R, C; stage_rc(tid * 16 + i * 8192, R, C); const int Rb = Epi::PERM ? ((R & ~31) + perm32(R & 31)) : R;
        voffA[i] = (unsigned)(R * K + C) * 2u; voffB[i] = (unsigned)(Rb * K + C) * 2u; }
    const size_t kstep = (size_t)(BK * 2);
    const size_t hstep = (size_t)HALF * K * 2;
    const size_t tstep = 2 * hstep;
    const unsigned ldsw = (unsigned)wid * 1024u;
    const int aoff = lds_byte(wr * 64 + fr, fq * 8), boff = lds_byte(wc * 32 + fr, fq * 8);
#define PG8_SA(b, h) (((b) * 2 + (h)) * HTB)
#define PG8_SB(b, h) ((4 + (b) * 2 + (h)) * HTB)
#define PG8_STAGE(bufoff, gbase, voff) do { _Pragma("unroll") for (int _i = 0; _i < 2; ++_i) \
        __builtin_amdgcn_global_load_lds((const unsigned*)((const char*)(gbase) + (voff)[_i]), (LAS unsigned*)(lds + (bufoff) + ldsw + _i * 8192), 16, 0, 0); } while (0)
#define PG8_LDA(dst, b, h) do { _Pragma("unroll") for (int m = 0; m < 4; ++m) _Pragma("unroll") for (int k = 0; k < 2; ++k) dst[m][k] = *(const LAS bf16x8*)(lds + PG8_SA(b, h) + aoff + m * 2048 + k * 1024); } while (0)
#define PG8_LDB(dst, b, h) do { _Pragma("unroll") for (int n = 0; n < 2; ++n) _Pragma("unroll") for (int k = 0; k < 2; ++k) dst[n][k] = *(const LAS bf16x8*)(lds + PG8_SB(b, h) + boff + n * 2048 + k * 1024); } while (0)
#define PG8_MMA(ai, bj, At, Bt) do { __builtin_amdgcn_s_setprio(1); _Pragma("unroll") for (int m = 0; m < 4; ++m) _Pragma("unroll") for (int n = 0; n < 2; ++n) _Pragma("unroll") for (int k = 0; k < 2; ++k) \
        acc[ai][bj][m][n] = __builtin_amdgcn_mfma_f32_16x16x32_bf16(Bt[n][k], At[m][k], acc[ai][bj][m][n], 0, 0, 0); __builtin_amdgcn_s_setprio(0); } while (0)
#define PG8_WAIT_V(n) asm volatile("s_waitcnt vmcnt(" #n ")" ::: "memory")
#define PG8_WAIT_L(n) asm volatile("s_waitcnt lgkmcnt(" #n ")" ::: "memory")
#define PG8_BAR __builtin_amdgcn_s_barrier()
#define PG8_SCHED __builtin_amdgcn_sched_barrier(0)
    Unit cur, nxt; int ui = 0;
    if (!S.next(0, cur)) return;
    Acc acc;
#pragma unroll
    for (int a = 0; a < 2; ++a)
#pragma unroll
        for (int b = 0; b < 2; ++b)
#pragma unroll
            for (int m = 0; m < 4; ++m)
#pragma unroll
                for (int n = 0; n < 2; ++n) acc[a][b][m][n] = (f32x4){0.f, 0.f, 0.f, 0.f};
    bf16x8 At[4][2], B0[2][2], B1[2][2];
    const char* cA = (const char*)g.A + (size_t)cur.pm * tstep; const char* cB = (const char*)g.Bt + (size_t)cur.pn * tstep;
    if constexpr (SP2) {
        PG8_STAGE(PG8_SB(0, 0), cB, voffB); PG8_STAGE(PG8_SB(0, 1), cB + hstep, voffB); PG8_STAGE(PG8_SA(0, 0), cA, voffA); PG8_STAGE(PG8_SA(0, 1), cA + hstep, voffA);
        if (wr == 1) PG8_BAR;
        PG8_WAIT_V(2); PG8_BAR;
        PG8_STAGE(PG8_SB(1, 0), cB + kstep, voffB); PG8_STAGE(PG8_SA(1, 0), cA + kstep, voffA); PG8_STAGE(PG8_SB(1, 1), cB + hstep + kstep, voffB);
        PG8_WAIT_V(6); PG8_BAR;
    } else {
        PG8_STAGE(PG8_SB(0, 0), cB, voffB); PG8_STAGE(PG8_SA(0, 0), cA, voffA); PG8_STAGE(PG8_SB(0, 1), cB + hstep, voffB); PG8_STAGE(PG8_SA(0, 1), cA + hstep, voffA);
        if (wr == 1) PG8_BAR;
        PG8_WAIT_V(4); PG8_BAR;
        PG8_STAGE(PG8_SB(1, 0), cB + kstep, voffB); PG8_STAGE(PG8_SA(1, 0), cA + kstep, voffA); PG8_STAGE(PG8_SB(1, 1), cB + hstep + kstep, voffB);
        PG8_WAIT_V(6); PG8_BAR;
    }
    for (;;) {
        const bool has_next = S.next(ui + 1, nxt);
        const char* nA = has_next ? (const char*)g.A + (size_t)nxt.pm * tstep : cA; const char* nB = has_next ? (const char*)g.Bt + (size_t)nxt.pn * tstep : cB;
        constexpr int NHALF = Epi::HOOK ? 2 : 1; const int tper = nt / NHALF;
        for (int hh = 0; hh < NHALF; ++hh) {
        if constexpr (Epi::HOOK) { if (hh == 1) { int fr_e = fr, fq_e = fq; asm volatile("" : "+v"(fr_e), "+v"(fq_e)); E.mid(acc, cur, wr, wc, fr_e, fq_e); } }
        for (int t = hh * tper; t < (hh + 1) * tper; t += 2) {
            const bool last = (t == nt - 2);
            const char* a1 = cA + (size_t)(t + 1) * kstep;
            const char* a2 = last ? nA : cA + (size_t)(t + 2) * kstep; const char* b2 = last ? nB : cB + (size_t)(t + 2) * kstep;
            const char* a3 = a2 + kstep; const char* b3 = b2 + kstep;
            if constexpr (SP2) {
            PG8_LDB(B0, 0, 0); PG8_LDB(B1, 0, 1); PG8_SCHED; PG8_LDA(At, 0, 0); PG8_STAGE(PG8_SA(1, 1), a1 + hstep, voffA);
            PG8_WAIT_V(8); PG8_WAIT_L(0); PG8_BAR; PG8_MMA(0, 0, At, B0); PG8_MMA(0, 1, At, B1); PG8_BAR; PG8_SCHED;
            PG8_LDA(At, 0, 1); PG8_STAGE(PG8_SB(0, 0), b2, voffB); PG8_STAGE(PG8_SB(0, 1), b2 + hstep, voffB); PG8_STAGE(PG8_SA(0, 0), a2, voffA);
            PG8_WAIT_V(8); PG8_WAIT_L(0); PG8_BAR; PG8_MMA(1, 0, At, B0); PG8_MMA(1, 1, At, B1); PG8_BAR; PG8_SCHED;
            PG8_LDB(B0, 1, 0); PG8_LDB(B1, 1, 1); PG8_SCHED; PG8_LDA(At, 1, 0); PG8_STAGE(PG8_SA(0, 1), a2 + hstep, voffA);
            PG8_WAIT_V(8); PG8_WAIT_L(0); PG8_BAR; PG8_MMA(0, 0, At, B0); PG8_MMA(0, 1, At, B1); PG8_BAR; PG8_SCHED;
            PG8_LDA(At, 1, 1); PG8_STAGE(PG8_SB(1, 0), b3, voffB); PG8_STAGE(PG8_SB(1, 1), b3 + hstep, voffB); PG8_STAGE(PG8_SA(1, 0), a3, voffA);
            PG8_WAIT_V(8); PG8_WAIT_L(0); PG8_BAR; PG8_MMA(1, 0, At, B0); PG8_MMA(1, 1, At, B1); PG8_BAR; PG8_SCHED;
            } else {
            PG8_LDB(B0, 0, 0); PG8_SCHED; PG8_LDA(At, 0, 0); PG8_STAGE(PG8_SA(1, 1), a1 + hstep, voffA);
            PG8_WAIT_L(8); PG8_BAR; PG8_WAIT_L(0); PG8_MMA(0, 0, At, B0); PG8_BAR; PG8_SCHED;
            PG8_LDB(B1, 0, 1); PG8_STAGE(PG8_SB(0, 0), b2, voffB);
            PG8_BAR; PG8_WAIT_L(0); PG8_MMA(0, 1, At, B1); PG8_BAR;
            PG8_LDA(At, 0, 1); PG8_STAGE(PG8_SA(0, 0), a2, voffA);
            PG8_BAR; PG8_WAIT_L(0); PG8_MMA(1, 0, At, B0); PG8_BAR; PG8_SCHED;
            PG8_STAGE(PG8_SB(0, 1), b2 + hstep, voffB);
            PG8_WAIT_V(6); PG8_BAR; PG8_MMA(1, 1, At, B1); PG8_BAR;
            PG8_LDB(B0, 1, 0); PG8_SCHED; PG8_LDA(At, 1, 0); PG8_STAGE(PG8_SA(0, 1), a2 + hstep, voffA);
            PG8_WAIT_L(8); PG8_BAR; PG8_WAIT_L(0); PG8_MMA(0, 0, At, B0); PG8_BAR; PG8_SCHED;
            PG8_LDB(B1, 1, 1); PG8_STAGE(PG8_SB(1, 0), b3, voffB);
            PG8_BAR; PG8_WAIT_L(0); PG8_MMA(0, 1, At, B1); PG8_BAR;
            PG8_LDA(At, 1, 1); PG8_STAGE(PG8_SA(1, 0), a3, voffA);
            PG8_BAR; PG8_WAIT_L(0); PG8_MMA(1, 0, At, B0); PG8_BAR; PG8_SCHED;
            PG8_STAGE(PG8_SB(1, 1), b3 + hstep, voffB);
            PG8_WAIT_V(6); PG8_BAR; PG8_MMA(1, 1, At, B1); PG8_BAR;
            }
        }
        }
        if constexpr (ALIGN_EPI) { if (wr == 0) PG8_BAR; }
        { int fr_e = fr, fq_e = fq; asm volatile("" : "+v"(fr_e), "+v"(fq_e)); E(acc, cur, wr, wc, fr_e, fq_e); }
        if (!has_next) break;
#pragma unroll
        for (int a = 0; a < 2; ++a)
#pragma unroll
            for (int b = 0; b < 2; ++b)
#pragma unroll
                for (int m = 0; m < 4; ++m)
#pragma unroll
                    for (int n = 0; n < 2; ++n) acc[a][b][m][n] = (f32x4){0.f, 0.f, 0.f, 0.f};
        cur = nxt; cA = nA; cB = nB; ++ui;
        if constexpr (ALIGN_EPI) { if (wr == 1) PG8_BAR; }
    }
    PG8_WAIT_V(0);
    if constexpr (!ALIGN_EPI) { if (wr == 0) PG8_BAR; }
    PG8_BAR;
#undef PG8_SA
#undef PG8_SB
#undef PG8_STAGE
#undef PG8_LDA
#undef PG8_LDB
#undef PG8_MMA
#undef PG8_WAIT_V
#undef PG8_WAIT_L
#undef PG8_BAR
#undef PG8_SCHED
}

struct EpiSwiGLU {
    static constexpr bool PERM = true, HOOK = false;
    bf16_t* O;
    __device__ __forceinline__ void mid(Acc&, const Unit&, int, int, int, int) const {}
    __device__ __forceinline__ void operator()(const Acc& acc, const Unit& u, int wr, int wc, int fr, int fq) const {
        const int row0 = u.pm * BM + wr * 64 + fr, col0 = u.pn * 128 + wc * 32 + 8 * fq;
#pragma unroll
        for (int ai = 0; ai < 2; ++ai)
#pragma unroll
            for (int m = 0; m < 4; ++m) {
                float r[8];
#pragma unroll
                for (int n = 0; n < 2; ++n)
#pragma unroll
                    for (int i = 0; i < 4; ++i) { const float a = acc[ai][0][m][n][i], b = acc[ai][1][m][n][i]; r[4 * n + i] = a * b * sigmoidf_(a); }
                u32x4 w; w.x = cvt_pk_bf16(r[0], r[1]); w.y = cvt_pk_bf16(r[2], r[3]); w.z = cvt_pk_bf16(r[4], r[5]); w.w = cvt_pk_bf16(r[6], r[7]);
                *(u32x4*)(O + (size_t)(row0 + ai * HALF + m * 16) * FF + col0) = w;
            }
    }
};
struct EpiResid {
    static constexpr bool PERM = false, HOOK = false;
    const float* base; float* out; float scale; const f32x2* st; const float* g; const float* b;
    __device__ __forceinline__ void mid(Acc&, const Unit&, int, int, int, int) const {}
    __device__ __forceinline__ void operator()(const Acc& acc, const Unit& u, int wr, int wc, int fr, int fq) const {
        const int row0 = u.pm * BM + wr * 64 + fr, col0 = u.pn * BM + wc * 32 + 4 * fq;
#pragma unroll
        for (int ai = 0; ai < 2; ++ai)
#pragma unroll
            for (int mh = 0; mh < 2; ++mh) {
                f32x4 pre[2][2][2]; f32x2 sv[2];
#pragma unroll
                for (int mm = 0; mm < 2; ++mm) { const int row = row0 + ai * HALF + (2 * mh + mm) * 16; const size_t off = (size_t)row * D + col0;
                    sv[mm] = st ? st[row] : (f32x2){0.f, 1.f};
#pragma unroll
                    for (int bj = 0; bj < 2; ++bj)
#pragma unroll
                        for (int n = 0; n < 2; ++n) pre[mm][bj][n] = *(const f32x4*)(base + off + bj * HALF + n * 16); }
                asm volatile("" ::: "memory");
#pragma unroll
                for (int bj = 0; bj < 2; ++bj)
#pragma unroll
                    for (int n = 0; n < 2; ++n) { f32x4 gv = (f32x4){ALPHA, ALPHA, ALPHA, ALPHA}, bv = (f32x4){0.f, 0.f, 0.f, 0.f};
                        if (st) { gv = *(const f32x4*)(g + col0 + bj * HALF + n * 16) * ALPHA; bv = *(const f32x4*)(b + col0 + bj * HALF + n * 16) * ALPHA; }
#pragma unroll
                        for (int mm = 0; mm < 2; ++mm) { const int m = 2 * mh + mm; const size_t off = (size_t)(row0 + ai * HALF + m * 16) * D + col0;
                            *(f32x4*)(out + off + bj * HALF + n * 16) = ((pre[mm][bj][n] - sv[mm].x) * sv[mm].y) * gv + bv + acc[ai][bj][m][n] * scale; } }
                asm volatile("" ::: "memory");
            }
    }
};
struct EpiMerge {
    static constexpr bool PERM = true, HOOK = true;
    const bf16_t* GA; const bf16_t* GB; bf16_t* O;
    __device__ __forceinline__ void mid(Acc& acc, const Unit& u, int wr, int wc, int fr, int fq) const {
        int row0 = u.pm * BM + wr * 64 + fr; const int col0 = u.pn * BM + wc * 32 + 8 * fq; asm volatile("" : "+v"(row0));
#pragma unroll
        for (int ai = 0; ai < 2; ++ai) {
            u32x4 ga[4][2], gb[4][2];
#pragma unroll
            for (int m = 0; m < 4; ++m)
#pragma unroll
                for (int bj = 0; bj < 2; ++bj) { const size_t off = (size_t)(row0 + ai * HALF + m * 16) * D + col0 + bj * HALF; ga[m][bj] = *(const u32x4*)(GA + off); gb[m][bj] = *(const u32x4*)(GB + off); }
            asm volatile("" ::: "memory");
#pragma unroll
            for (int m = 0; m < 4; ++m)
#pragma unroll
                for (int bj = 0; bj < 2; ++bj) {
#pragma unroll
                    for (int k = 0; k < 4; ++k) { const float rl = bf_lo(ga[m][bj][k]) * __builtin_amdgcn_rcpf(bf_lo(gb[m][bj][k])), rh = bf_hi(ga[m][bj][k]) * __builtin_amdgcn_rcpf(bf_hi(gb[m][bj][k]));
                        acc[ai][bj][m][k >> 1][(k & 1) * 2] *= rl; acc[ai][bj][m][k >> 1][(k & 1) * 2 + 1] *= rh; } }
            asm volatile("" ::: "memory");
        }
    }
    __device__ __forceinline__ void operator()(const Acc& acc, const Unit& u, int wr, int wc, int fr, int fq) const {
        const int row0 = u.pm * BM + wr * 64 + fr, col0 = u.pn * BM + wc * 32 + 8 * fq;
#pragma unroll
        for (int ai = 0; ai < 2; ++ai) {
            u32x4 gb[4][2];
#pragma unroll
            for (int m = 0; m < 4; ++m)
#pragma unroll
                for (int bj = 0; bj < 2; ++bj) gb[m][bj] = *(const u32x4*)(GB + (size_t)(row0 + ai * HALF + m * 16) * D + col0 + bj * HALF);
            asm volatile("" ::: "memory");
#pragma unroll
            for (int m = 0; m < 4; ++m)
#pragma unroll
                for (int bj = 0; bj < 2; ++bj) { u32x4 w;
#pragma unroll
                    for (int k = 0; k < 4; ++k) w[k] = cvt_pk_bf16(acc[ai][bj][m][k >> 1][(k & 1) * 2] * bf_lo(gb[m][bj][k]), acc[ai][bj][m][k >> 1][(k & 1) * 2 + 1] * bf_hi(gb[m][bj][k]));
                    *(u32x4*)(O + (size_t)(row0 + ai * HALF + m * 16) * D + col0 + bj * HALF) = w; }
            asm volatile("" ::: "memory");
        }
    }
};
struct EpiInProj {
    static constexpr bool PERM = true, HOOK = false;
    bf16_t* HCAT; bf16_t* VB; bf16_t* KB; bf16_t* VALB; bf16_t* GA; bf16_t* GB; const float* gate_b; const float* rope;
    __device__ __forceinline__ void mid(Acc&, const Unit&, int, int, int, int) const {}
    __device__ __forceinline__ void operator()(const Acc& acc, const Unit& u, int wr, int wc, int fr, int fq) const {
        const int row0 = u.pm * BM + wr * 64 + fr; const int sec = u.pn >> 2, tl = u.pn & 3;
        if (sec == 2 || sec == 3) {
            bf16_t* dst = (sec == 2) ? (HCAT + 1024) : KB; const int pitch = (sec == 2) ? 2048 : 1024; const float sc = (sec == 2) ? C2 : 1.0f;
            const int col0 = tl * 256 + wc * 64 + 8 * fq;
#pragma unroll
            for (int ai = 0; ai < 2; ++ai)
#pragma unroll
                for (int m = 0; m < 4; ++m) { const int row = row0 + ai * HALF + m * 16; const float* cs = rope + (size_t)(row & (SEQ - 1)) * 64 + 8 * fq;
                    u32x4 w1, w2;
#pragma unroll
                    for (int n = 0; n < 2; ++n) { const f32x4 c = *(const f32x4*)(cs + 4 * n) * sc, s = *(const f32x4*)(cs + 32 + 4 * n) * sc;
                        const f32x4 x1 = acc[ai][0][m][n], x2 = acc[ai][1][m][n]; const f32x4 o1 = x1 * c - x2 * s, o2 = x2 * c + x1 * s;
                        w1[2 * n] = cvt_pk_bf16(o1[0], o1[1]); w1[2 * n + 1] = cvt_pk_bf16(o1[2], o1[3]); w2[2 * n] = cvt_pk_bf16(o2[0], o2[1]); w2[2 * n + 1] = cvt_pk_bf16(o2[2], o2[3]); }
                    bf16_t* p = (sec == 2) ? dst + (size_t)row * pitch + col0
                                           : dst + ((size_t)(((row >> 14) * 8 + tl * 2 + (wc >> 1)) * SEQ + (row & (SEQ - 1)))) * 128 + (wc & 1) * 64 + 8 * fq;
                    *(u32x4*)p = w1; *(u32x4*)(p + 32) = w2; asm volatile("" ::: "memory"); }
            return;
        }
        bf16_t* dst; int pitch; int mode;
        if (sec == 0) { dst = HCAT; pitch = 2048; mode = 1; } else if (sec == 1) { dst = VB; pitch = 1024; mode = 1; } else if (sec == 4) { dst = VALB; pitch = 1024; mode = 0; }
        else if (sec == 5) { dst = GA; pitch = 1024; mode = 2; } else { dst = GB; pitch = 1024; mode = 2; }
        const int col0 = tl * 256 + wc * 32 + 8 * fq;
        const float* gbp = gate_b + (mode == 2 ? (sec - 5) * 1024 + col0 : 0);
#pragma unroll
        for (int ai = 0; ai < 2; ++ai)
#pragma unroll
            for (int m = 0; m < 4; ++m) { const int row = row0 + ai * HALF + m * 16; bf16_t* rowp = dst + (size_t)row * pitch + col0;
                if (mode == 0) rowp = dst + ((size_t)(((row >> 14) * 8 + tl * 2) * SEQ + (row & (SEQ - 1)))) * 128 + wc * 32 + 8 * fq;
#pragma unroll
                for (int bj = 0; bj < 2; ++bj) { f32x4 v0 = acc[ai][bj][m][0], v1 = acc[ai][bj][m][1];
                    if (mode == 1) { f32x2 a = gelu_pk((f32x2){v0[0], v0[1]}), b = gelu_pk((f32x2){v0[2], v0[3]}), c = gelu_pk((f32x2){v1[0], v1[1]}), d = gelu_pk((f32x2){v1[2], v1[3]});
                        v0 = (f32x4){a.x, a.y, b.x, b.y}; v1 = (f32x4){c.x, c.y, d.x, d.y}; }
                    else if (mode == 2) { v0 = v0 + *(const f32x4*)(gbp + bj * HALF); v1 = v1 + *(const f32x4*)(gbp + bj * HALF + 4);
#pragma unroll
                        for (int i = 0; i < 4; ++i) { v0[i] = sigmoidf_(v0[i]); v1[i] = sigmoidf_(v1[i]); } }
                    u32x4 w; w.x = cvt_pk_bf16(v0[0], v0[1]); w.y = cvt_pk_bf16(v0[2], v0[3]); w.z = cvt_pk_bf16(v1[0], v1[1]); w.w = cvt_pk_bf16(v1[2], v1[3]);
                    *(u32x4*)(rowp + (mode == 0 ? (size_t)bj * SEQ * 128 : (size_t)bj * HALF)) = w; } }
    }
};
}

namespace att {
__device__ __forceinline__ int crow(int r, int hi) { return (r & 3) + 8 * (r >> 2) + 4 * hi; }
__device__ __forceinline__ void glds16(const void* gsrc, unsigned lds_dst) { unsigned keep;
    asm volatile("s_mov_b32 %0, m0\n\ts_mov_b32 m0, %2\n\ts_nop 0\n\tglobal_load_lds_dwordx4 %1, off\n\ts_mov_b32 m0, %0" : "=&s"(keep) : "v"(gsrc), "s"(lds_dst) : "memory"); }
typedef short v4i16_t __attribute__((ext_vector_type(4)));
__device__ __forceinline__ s16x4 vtr(LAS const unsigned char* p) { return __builtin_bit_cast(s16x4, __builtin_amdgcn_ds_read_tr16_b64_v4i16((LAS v4i16_t*)p)); }
#define ATT_MFMA(a, b, c) __builtin_amdgcn_mfma_f32_32x32x16_bf16(a, b, c, 0, 0, 0)
constexpr int STAGE = 32768;
constexpr int NSTAGE = 4;
constexpr int XOFF = 0;
constexpr int XRG = 32 * 136;
constexpr int WSOFF = NSTAGE * STAGE;

__device__ __forceinline__ float fadd_s(float a, float b) { float r = a + b; asm("" : "+v"(r)); return r; }
struct DmaT { const bf16_t* k; const bf16_t* v; unsigned dk, dv; bool on; };
__device__ __forceinline__ void dma_piece(const DmaT& d, int i) {
    if (!d.on) return;
    if (i == 0) glds16(d.k, (unsigned)__builtin_amdgcn_readfirstlane(d.dk)); else if (i == 1) glds16(d.k + 64, (unsigned)__builtin_amdgcn_readfirstlane(d.dk + 8192));
    else if (i == 2) glds16(d.v, (unsigned)__builtin_amdgcn_readfirstlane(d.dv)); else glds16(d.v + 16 * 128, (unsigned)__builtin_amdgcn_readfirstlane(d.dv + 1024));
}
template <bool SLOW>
__device__ __forceinline__ void stepX(u32x4 (&pw)[4], f32x16& p1, float& l, f32x16& negm, const bf16x8 (&qr)[4], LAS const unsigned char* ka, LAS const unsigned char* kb, int kv0, int qpos, int hi, const bool first, LAS const unsigned char* vb, s16x4 (&vlo)[4], s16x4 (&vhh)[4], const DmaT& dma) {
    f32x16 p0;
    if (SLOW && first) {
#pragma unroll
        for (int r = 0; r < 16; ++r) negm[r] = 0.f;
    }
    bf16x8 kf[8];
#pragma unroll
    for (int d0 = 0; d0 < 4; ++d0) { LAS const unsigned char* kp = ((d0 & 1) ? kb : ka) + (d0 >> 1) * 512; kf[d0] = *(LAS const bf16x8*)(kp); }
#pragma unroll
    for (int d0 = 0; d0 < 4; ++d0) { LAS const unsigned char* kp = ((d0 & 1) ? kb : ka) + (d0 >> 1) * 512; kf[4 + d0] = *(LAS const bf16x8*)(kp + 4096); }
    __builtin_amdgcn_s_setprio(2);
    p0 = ATT_MFMA(kf[0], qr[0], negm);
#pragma unroll
    for (int d0 = 1; d0 < 4; ++d0) p0 = ATT_MFMA(kf[d0], qr[d0], p0);
    if (!SLOW) __builtin_amdgcn_sched_barrier(0);
    if (SLOW) {
        p1 = ATT_MFMA(kf[4], qr[0], negm);
#pragma unroll
        for (int d0 = 1; d0 < 4; ++d0) p1 = ATT_MFMA(kf[4 + d0], qr[d0], p1);
        __builtin_amdgcn_s_setprio(0);
        __builtin_amdgcn_sched_barrier(0);
    }
    if (SLOW) {
        int dq = qpos - kv0 - 4 * hi; asm volatile("" : "+v"(dq));
#pragma unroll
        for (int r = 0; r < 16; ++r) { const int cr = (r & 3) + 8 * (r >> 2); p0[r] = (cr > dq) ? -INFINITY : p0[r]; p1[r] = (cr + 32 > dq) ? -INFINITY : p1[r]; }
    }
    if (SLOW && first) {
        float rm = fmaxf(p0[0], p1[0]);
#pragma unroll
        for (int r = 1; r < 16; ++r) rm = fmaxf(rm, fmaxf(p0[r], p1[r]));
        rm = fmaxf(rm, __shfl_xor(rm, 32));
#pragma unroll
        for (int r = 0; r < 16; ++r) { p0[r] -= rm; p1[r] -= rm; negm[r] = -rm; }
    }
    float sa = 0.f, sb = 0.f;
    if (!SLOW) {
#pragma unroll
        for (int g = 0; g < 4; ++g) {
            p1 = (g == 0) ? ATT_MFMA(kf[4], qr[0], negm) : ATT_MFMA(kf[4 + g], qr[g], p1);
#pragma unroll
            for (int r = 4 * g; r < 4 * g + 4; r += 2) { p0[r] = __builtin_amdgcn_exp2f(p0[r]); p0[r + 1] = __builtin_amdgcn_exp2f(p0[r + 1]); sa = fadd_s(sa, p0[r]); sb = fadd_s(sb, p0[r + 1]); }
            if (g & 1) { const int w = g >> 1;
#pragma unroll
                for (int k = 0; k < 4; ++k) pw[w][k] = cvtpk_s(p0[8 * w + 2 * k], p0[8 * w + 2 * k + 1]); }
            dma_piece(dma, g);
            __builtin_amdgcn_sched_barrier(0);
        }
        l += sa + sb;
        __builtin_amdgcn_s_setprio(0);
    } else {
#pragma unroll
        for (int r = 0; r < 16; r += 2) { p0[r] = __builtin_amdgcn_exp2f(p0[r]); p0[r + 1] = __builtin_amdgcn_exp2f(p0[r + 1]); sa = fadd_s(sa, p0[r]); sb = fadd_s(sb, p0[r + 1]); }
        l += sa + sb;
#pragma unroll
        for (int k = 0; k < 4; ++k) { pw[0][k] = cvtpk_s(p0[2 * k], p0[2 * k + 1]); pw[1][k] = cvtpk_s(p0[8 + 2 * k], p0[8 + 2 * k + 1]); }
    }
#pragma unroll
    for (int j = 0; j < 4; ++j) { vlo[j] = vtr(vb + j * 4096); vhh[j] = vtr(vb + j * 4096 + 512); }
}
__device__ __forceinline__ void stepY(f32x16 (&o)[4], u32x4 (&pw)[4], f32x16& p1, float& l, LAS const unsigned char* vb, const s16x4 (&vlo)[4], const s16x4 (&vhh)[4], const DmaT& dma) {
    __builtin_amdgcn_sched_barrier(0);
    s16x4 lo[16], hh[16];
#define ATT_VRD(j) do { lo[j] = vtr(vb + ((j) & 3) * 4096 + ((j) >> 2) * 1024); hh[j] = vtr(vb + ((j) & 3) * 4096 + ((j) >> 2) * 1024 + 512); } while (0)
#pragma unroll
    for (int j = 0; j < 4; ++j) { lo[j] = vlo[j]; hh[j] = vhh[j]; }
    float sa = 0.f, sb = 0.f;
#pragma unroll
    for (int j = 0; j < 16; ++j) {
        if (j + 4 < 16) ATT_VRD(j + 4);
        { const bf16x8 vf = (bf16x8){lo[j][0], lo[j][1], lo[j][2], lo[j][3], hh[j][0], hh[j][1], hh[j][2], hh[j][3]};
          o[j & 3] = ATT_MFMA(__builtin_bit_cast(bf16x8, pw[j >> 2]), vf, o[j & 3]); }
        if (j < 8) { p1[2 * j] = __builtin_amdgcn_exp2f(p1[2 * j]); p1[2 * j + 1] = __builtin_amdgcn_exp2f(p1[2 * j + 1]); sa = fadd_s(sa, p1[2 * j]); sb = fadd_s(sb, p1[2 * j + 1]); }
        if (j == 3 || j == 7) { const int w = j >> 2;
#pragma unroll
            for (int k = 0; k < 4; ++k) pw[2 + w][k] = cvtpk_s(p1[8 * w + 2 * k], p1[8 * w + 2 * k + 1]); }
        if (j >= 8 && j < 12) dma_piece(dma, j - 8);
        __builtin_amdgcn_sched_barrier(0);
    }
#undef ATT_VRD
    l += sa + sb;
}

struct Params { const bf16_t* Q; const bf16_t* K; const bf16_t* V; bf16_t* O; const float* g; float lam, oscale; };

template <int GRP>
__device__ __forceinline__ void run_tiles(f32x16 (&o)[4], float& l, const bf16x8 (&qr)[4], LAS unsigned char* lds, const unsigned ldsbase, const bf16_t* ksrc, const bf16_t* vsrc, int wid, int NT, int qa, int qpos, int hi, int kA, int kB, int voff) {
#define ATT_DMA(t, sboff) do { const unsigned sb_ = ldsbase + (unsigned)(sboff); const size_t go_ = (size_t)(t) * 64 * 128; \
        glds16(ksrc + go_, (unsigned)__builtin_amdgcn_readfirstlane(sb_ + wid * 1024)); \
        glds16(ksrc + go_ + 64, (unsigned)__builtin_amdgcn_readfirstlane(sb_ + 8192 + wid * 1024)); \
        glds16(vsrc + go_, (unsigned)__builtin_amdgcn_readfirstlane(sb_ + 16384 + (wid >> 1) * 4096 + (wid & 1) * 2048)); \
        glds16(vsrc + go_ + 16 * 128, (unsigned)__builtin_amdgcn_readfirstlane(sb_ + 16384 + (wid >> 1) * 4096 + (wid & 1) * 2048 + 1024)); } while (0)
#define END_EVEN() asm volatile("s_waitcnt lgkmcnt(0)\n\ts_barrier" ::: "memory")
#define END_ODD4() asm volatile("s_waitcnt vmcnt(4) lgkmcnt(0)\n\ts_barrier" ::: "memory")
#define END_ODD8() asm volatile("s_waitcnt vmcnt(8) lgkmcnt(0)\n\ts_barrier" ::: "memory")
#define END_ODDN(nn) do { if ((nn) >= 2) END_ODD8(); else if ((nn) == 1) END_ODD4(); else END_ODD0(); } while (0)
#define END_ODD0() asm volatile("s_waitcnt vmcnt(0) lgkmcnt(0)\n\ts_barrier" ::: "memory")
#define NXT(s) (((s) == (NSTAGE - 1) * STAGE) ? 0 : (s) + STAGE)
    u32x4 pw[4]; f32x16 negm, p1k; s16x4 vlo[4], vhh[4]; DmaT dma_off; dma_off.k = ksrc; dma_off.v = vsrc; dma_off.dk = 0u; dma_off.dv = 0u; dma_off.on = false;
#pragma unroll
    for (int j = 0; j < 4; ++j) { vlo[j] = (s16x4){0, 0, 0, 0}; vhh[j] = (s16x4){0, 0, 0, 0}; }
#pragma unroll
    for (int r = 0; r < 16; ++r) p1k[r] = 0.f;
#pragma unroll
    for (int k = 0; k < 4; ++k) pw[k] = (u32x4){0u, 0u, 0u, 0u};
#define SLOW_X(t, sc) do { const int kv0_ = 64 * (t); if (kv0_ <= qa + 31) stepX<true>(pw, p1k, l, negm, qr, lds + (sc) + kA, lds + (sc) + kB, kv0_, qpos, hi, (t) == 0, lds + (sc) + voff, vlo, vhh, dma_off); } while (0)
#define SLOW_Y(t, sc) do { if (64 * (t) <= qa + 31) stepY(o, pw, p1k, l, lds + (sc) + voff, vlo, vhh, dma_off); } while (0)
    int sc = 0;
    if (GRP == 1) END_EVEN();
#define TILE_SLOW(t) do { const int s3_ = (sc == 0) ? (NSTAGE - 1) * STAGE : sc - STAGE; const bool iss_ = ((t) + 3 < NT); const int newer_ = ((t) + 3 < NT ? 1 : 0) + ((t) + 2 < NT ? 1 : 0); \
        if (GRP == 0) { SLOW_X(t, sc); END_EVEN(); if (iss_) ATT_DMA((t) + 3, s3_); SLOW_Y(t, sc); END_ODDN(newer_); } \
        else          { if (iss_) ATT_DMA((t) + 3, s3_); SLOW_X(t, sc); END_ODDN(newer_); SLOW_Y(t, sc); END_EVEN(); } \
        sc = NXT(sc); } while (0)
    TILE_SLOW(0);
    int t = 1;
    for (; t < NT - 3; ++t) {
        const int s3 = (sc == 0) ? (NSTAGE - 1) * STAGE : sc - STAGE;
        DmaT dma; { const size_t go_ = (size_t)(t + 3) * 64 * 128; dma.k = ksrc + go_; dma.v = vsrc + go_; dma.dk = ldsbase + (unsigned)s3 + wid * 1024; dma.dv = ldsbase + (unsigned)s3 + 16384 + (wid >> 1) * 4096 + (wid & 1) * 2048; dma.on = true; }
        if (GRP == 0) { stepX<false>(pw, p1k, l, negm, qr, lds + sc + kA, lds + sc + kB, 64 * t, qpos, hi, false, lds + sc + voff, vlo, vhh, dma_off); END_EVEN(); stepY(o, pw, p1k, l, lds + sc + voff, vlo, vhh, dma); END_ODD8(); }
        else          { stepX<false>(pw, p1k, l, negm, qr, lds + sc + kA, lds + sc + kB, 64 * t, qpos, hi, false, lds + sc + voff, vlo, vhh, dma); END_ODD8(); stepY(o, pw, p1k, l, lds + sc + voff, vlo, vhh, dma_off); END_EVEN(); }
        sc = NXT(sc);
    }
    for (; t < NT; ++t) TILE_SLOW(t);
#undef TILE_SLOW
    if (GRP == 0) END_EVEN();
#undef SLOW_X
#undef SLOW_Y
}

__device__ __forceinline__ void unit(int b, int h, int qb, const Params& P, LAS unsigned char* lds, const int tid) {
    const int lane = tid & 63, r32 = lane & 31, hi = lane >> 5; const int wid = __builtin_amdgcn_readfirstlane(tid >> 6);
    const int rg = wid >> 1, mp = wid & 1;
    const size_t rowbase = (size_t)b * SEQ; const int q0 = qb * 128, NT = 2 * qb + 2, qa = q0 + 32 * rg, qpos = qa + r32;
    const unsigned ldsbase = (unsigned)(uintptr_t)lds;
    const size_t hbase = (size_t)(b * 8 + h) * SEQ;
    const bf16_t* ksrc = P.K + (hbase + 8 * wid + (lane & 7)) * 128 + (((lane >> 3) ^ (wid & 3)) * 8);
    const bf16_t* vsrc = P.V + (hbase + 32 * (wid & 1) + (lane >> 2)) * 128 + (wid >> 1) * 32 + (lane & 3) * 8;
#define ATT_WAITBAR() asm volatile("s_waitcnt vmcnt(0) lgkmcnt(0)\n\ts_barrier" ::: "memory")
    ATT_DMA(0, 0); ATT_DMA(1, STAGE); if (NT > 2) ATT_DMA(2, 2 * STAGE);
    bf16x8 qr[4];
    { const bf16_t* Qp = P.Q + (rowbase + qpos) * 2048 + h * 128 + mp * 64 + 8 * hi;
#pragma unroll
      for (int d0 = 0; d0 < 4; ++d0) qr[d0] = *(const bf16x8*)(Qp + 16 * d0); }
    f32x16 o[4];
#pragma unroll
    for (int d = 0; d < 4; ++d)
#pragma unroll
        for (int r = 0; r < 16; ++r) o[d][r] = 0.f;
    float l = 0.f;
    LAS float* wsf = (LAS float*)(lds + WSOFF) + wid * 64;
    const int kg = r32 >> 3, kbase0 = mp * 8192 + kg * 1024 + ((hi ^ (kg & 1)) * 128) + (r32 & 7) * 16;
    const int kA = kbase0 + 256 * (kg >> 1), kB = kbase0 + 256 * (1 - (kg >> 1));
    const int voff = 16384 + ((lane >> 4) & 1) * 32 + (lane & 3) * 8 + (4 * hi + ((lane & 15) >> 2)) * 64;
    ATT_WAITBAR();
    asm volatile("" :: "v"(qr[0]), "v"(qr[1]), "v"(qr[2]), "v"(qr[3]));
    if (wid < 4) run_tiles<0>(o, l, qr, lds, ldsbase, ksrc, vsrc, wid, NT, qa, qpos, hi, kA, kB, voff);
    else         run_tiles<1>(o, l, qr, lds, ldsbase, ksrc, vsrc, wid, NT, qa, qpos, hi, kA, kB, voff);
    int hi_e = hi, r32_e = r32; asm volatile("" : "+v"(hi_e), "+v"(r32_e));
    l += __shfl_xor(l, 32);
    const float inv = 1.0f / l;
    wsf[r32_e] = inv;
    LAS const float* wsr = wsf + 4 * hi_e;
#pragma unroll
    for (int r = 0; r < 16; ++r) { const float il = wsr[crow(r, 0)];
#pragma unroll
        for (int d = 0; d < 4; ++d) o[d][r] *= il; }
    LAS float* XB = (LAS float*)(lds + XOFF) + rg * XRG;
    LAS float* X = XB + (4 * hi_e) * 136 + r32_e;
    if (mp == 1) {
#pragma unroll
        for (int r = 0; r < 16; ++r)
#pragma unroll
            for (int d = 0; d < 4; ++d) X[crow(r, 0) * 136 + (d >> 1) * 68 + (d & 1) * 32] = o[d][r];
    }
    ATT_WAITBAR();
    if (mp == 0) {
#pragma unroll
        for (int r = 0; r < 16; ++r)
#pragma unroll
            for (int d = 0; d < 4; ++d) { LAS float* xp = X + crow(r, 0) * 136 + (d >> 1) * 68 + (d & 1) * 32; *xp = o[d][r] - P.lam * (*xp); }
        asm volatile("s_waitcnt lgkmcnt(0)" ::: "memory");
        int lane_e = r32_e + 32 * hi_e; const int row = lane_e >> 1, half = lane_e & 1;
        LAS const f32x4* rp = (LAS const f32x4*)(XB + row * 136 + half * 68);
        f32x4 v4[16]; float ss = 0.f;
#pragma unroll
        for (int k = 0; k < 16; ++k) { v4[k] = rp[k]; ss += (v4[k].x * v4[k].x + v4[k].y * v4[k].y) + (v4[k].z * v4[k].z + v4[k].w * v4[k].w); }
        ss += __shfl_xor(ss, 1);
        const float rs = __builtin_amdgcn_rsqf(ss * (1.0f / 128.0f) + LN_EPS) * P.oscale;
        bf16_t* op = P.O + (rowbase + qa + row) * 2048 + h * 128 + half * 64; const float* gp = P.g + half * 64;
#pragma unroll
        for (int k = 0; k < 8; ++k) { const f32x4 g0 = *(const f32x4*)(gp + 8 * k) * rs, g1 = *(const f32x4*)(gp + 8 * k + 4) * rs; const f32x4 a0 = v4[2 * k] * g0, a1 = v4[2 * k + 1] * g1;
            u32x4 w; w.x = cvt_pk_bf16(a0.x, a0.y); w.y = cvt_pk_bf16(a0.z, a0.w); w.z = cvt_pk_bf16(a1.x, a1.y); w.w = cvt_pk_bf16(a1.z, a1.w);
            *(u32x4*)(op + 8 * k) = w; }
    }
    ATT_WAITBAR();
#undef ATT_DMA
#undef END_EVEN
#undef END_ODD4
#undef END_ODD8
#undef END_ODDN
#undef END_ODD0
#undef NXT
}
}

struct Args { const float* in[16]; float* out; unsigned char* ws; float invf[32]; float lam_init[4]; int ph_lo, ph_hi, coop, pad; };

struct Ctx { int tid, lane, wave, gw, NGW; LAS unsigned char* lds; };

__device__ __forceinline__ void tr_item(const float* W, int ldw, int k0, int n0, bf16_t* dst, int pitch, int drow0, int dcol0, LAS float* scr, int lane) {
    float wv[32];
#pragma unroll
    for (int i = 0; i < 32; ++i) { const int kk = 2 * i + (lane >> 5); wv[i] = W[(size_t)(k0 + kk) * ldw + n0 + (lane & 31)]; }
#pragma unroll
    for (int i = 0; i < 32; ++i) { const int kk = 2 * i + (lane >> 5); scr[kk * 33 + (lane & 31)] = wv[i]; }
    asm volatile("s_waitcnt lgkmcnt(0)" ::: "memory");
    const int c = lane & 7;
#pragma unroll
    for (int j = 0; j < 4; ++j) { const int n = (lane >> 3) + 8 * j; const LAS float* s = scr + (8 * c) * 33 + n;
        u32x4 o; o.x = cvt_pk_bf16(s[0 * 33], s[1 * 33]); o.y = cvt_pk_bf16(s[2 * 33], s[3 * 33]); o.z = cvt_pk_bf16(s[4 * 33], s[5 * 33]); o.w = cvt_pk_bf16(s[6 * 33], s[7 * 33]);
        *(u32x4*)(dst + (size_t)(drow0 + n) * pitch + dcol0 + 8 * c) = o; }
    asm volatile("s_waitcnt lgkmcnt(0)" ::: "memory");
}
__device__ __forceinline__ void conv_ffn(const Ctx& C, const Args& a, int l, int f) {
    LAS float* scr = (LAS float*)(C.lds + C.wave * 8448);
    const size_t wo = (size_t)(l * 2 + f) * D * FF;
    const float* w1 = a.in[11] + wo; const float* w3 = a.in[12] + wo; const float* w2 = a.in[13] + wo;
    bf16_t* WUP = (bf16_t*)(a.ws + WS_WUP); bf16_t* W2 = (bf16_t*)(a.ws + WS_W2);
    for (int it = C.gw; it < 4224; it += C.NGW) {
        if (it < 2816) { const int r = it < 1408 ? it : it - 1408; const int kb = r / 88, nb = r % 88, n0 = 32 * nb;
            tr_item(it < 1408 ? w1 : w3, FF, 64 * kb, n0, WUP, D, (n0 >> 7) * 256 + (n0 & 127) + (it < 1408 ? 0 : 128), 64 * kb, scr, C.lane); }
        else { const int r = it - 2816, kb = r >> 5, nb = r & 31; tr_item(w2, D, 64 * kb, 32 * nb, W2, FF, 32 * nb, 64 * kb, scr, C.lane); }
    }
}
__device__ __forceinline__ void conv_mixer(const Ctx& C, const Args& a, int l) {
    LAS float* scr = (LAS float*)(C.lds + C.wave * 8448);
    const float* win = a.in[1] + (size_t)l * D * INW; const float* wbr = a.in[9] + (size_t)l * 2 * D * D; const float* wout = a.in[10] + (size_t)l * D * D;
    bf16_t* WIN = (bf16_t*)(a.ws + WS_WIN); bf16_t* WBR = (bf16_t*)(a.ws + WS_WBR); bf16_t* WOUT = (bf16_t*)(a.ws + WS_WOUT);
    for (int it = C.gw; it < 5120; it += C.NGW) {
        if (it < 3584) { const int kb = it / 224, nb = it % 224, n0 = 32 * nb; int dr = n0;
            if (n0 >= 2048 && n0 < 4096) { const int w = n0 & 255; dr = (n0 & ~255) + ((w >> 5) & 1) * 128 + (w >> 6) * 32; }
            tr_item(win, INW, 64 * kb, n0, WIN, D, dr, 64 * kb, scr, C.lane); }
        else if (it < 4608) { const int r = it - 3584, br = r >> 9, q = r & 511, kb = q >> 5, nb = q & 31; tr_item(wbr + (size_t)br * D * D, D, 64 * kb, 32 * nb, WBR, 2048, 32 * nb, br * 1024 + 64 * kb, scr, C.lane); }
        else { const int q = it - 4608, kb = q >> 5, nb = q & 31; tr_item(wout, D, 64 * kb, 32 * nb, WOUT, D, 32 * nb, 64 * kb, scr, C.lane); }
    }
    const float* sw = a.in[5] + (size_t)l * 8 * 128 * 128; bf16_t* SW = (bf16_t*)(a.ws + WS_SGUW);
    for (int i = C.gw * 64 + C.lane; i < 8 * 128 * 128 / 2; i += C.NGW * 64) { const int e = 2 * i, r = e & 127, t = (e >> 7) & 127;
        const f32x2 v = *(const f32x2*)(sw + e); *(unsigned*)(SW + e) = cvt_pk_bf16(r <= t ? v.x : 0.f, (r + 1) <= t ? v.y : 0.f); }
}
__device__ __forceinline__ void ln_rows(const Ctx& C, float* y, bf16_t* xb, const float* g, const float* b, f32x2* stats, const bool write_f32) {
    f32x4 gg[4], bb[4];
#pragma unroll
    for (int j = 0; j < 4; ++j) { gg[j] = ((const f32x4*)g)[C.lane + 64 * j]; bb[j] = ((const f32x4*)b)[C.lane + 64 * j]; }
    for (int m = C.gw; m < T; m += C.NGW) {
        f32x4* row = (f32x4*)(y + (size_t)m * D) + C.lane; f32x4 v[4]; float s = 0.f;
#pragma unroll
        for (int j = 0; j < 4; ++j) { v[j] = row[64 * j]; s += (v[j].x + v[j].y) + (v[j].z + v[j].w); }
        const float mean = wave_sum(s) * (1.f / D); float s2 = 0.f;
#pragma unroll
        for (int j = 0; j < 4; ++j) { v[j] = v[j] - mean; s2 += (v[j].x * v[j].x + v[j].y * v[j].y) + (v[j].z * v[j].z + v[j].w * v[j].w); }
        const float rstd = 1.f / sqrtf(wave_sum(s2) * (1.f / D) + LN_EPS);
        if (C.lane == 0) stats[m] = (f32x2){mean, rstd};
        u32x2* o8 = (u32x2*)(xb + (size_t)m * D) + C.lane;
#pragma unroll
        for (int j = 0; j < 4; ++j) { const f32x4 o = v[j] * rstd * gg[j] + bb[j]; if (write_f32) row[64 * j] = o; u32x2 w; w.x = cvt_pk_bf16(o.x, o.y); w.y = cvt_pk_bf16(o.z, o.w); o8[64 * j] = w; }
    }
}
__device__ __forceinline__ void prologue(const Ctx& C, const Args& a) {
    const float* x = a.in[0]; bf16_t* xb = (bf16_t*)(a.ws + WS_XB);
    for (int m = C.gw; m < T; m += C.NGW) { const f32x4* row = (const f32x4*)(x + (size_t)m * D) + C.lane; u32x2* o8 = (u32x2*)(xb + (size_t)m * D) + C.lane;
#pragma unroll
        for (int j = 0; j < 4; ++j) { const f32x4 v = row[64 * j]; u32x2 w; w.x = cvt_pk_bf16(v.x, v.y); w.y = cvt_pk_bf16(v.z, v.w); o8[64 * j] = w; } }
    float* rope = (float*)(a.ws + WS_ROPE);
    for (int i = C.gw * 64 + C.lane; i < SEQ * 32; i += C.NGW * 64) { const int pos = i >> 5, j = i & 31;
        const float ang = __fmul_rn((float)pos, a.invf[j]); const double ad = (double)ang;
        const double n = __builtin_rint(ad * 0.15915494309189535); const double r = (ad - n * 6.283185307179586) - n * 2.4492935982947064e-16; const double r2 = r * r;
        double sn = 1.0, cs = 1.0;
#pragma unroll
        for (int k = 13; k >= 1; --k) { sn = 1.0 - r2 * (1.0 / (double)((2 * k) * (2 * k + 1))) * sn; cs = 1.0 - r2 * (1.0 / (double)((2 * k - 1) * (2 * k))) * cs; }
        sn *= r;
        rope[(size_t)pos * 64 + j] = (float)cs; rope[(size_t)pos * 64 + 32 + j] = (float)sn; }
    conv_ffn(C, a, 0, 0);
}
__device__ __forceinline__ void sgu_chunk(const Ctx& C, const Args& a, int l, int n) {
    LAS unsigned char* lds = C.lds; LAS f32x2* stats = (LAS f32x2*)lds; LAS unsigned char* vimg = lds + 1024;
    const bf16_t* VB = (const bf16_t*)(a.ws + WS_V); bf16_t* HC = (bf16_t*)(a.ws + WS_HCAT); const bf16_t* SW = (const bf16_t*)(a.ws + WS_SGUW);
    const float* gam = a.in[3] + l * D; const float* bet = a.in[4] + l * D; const float* sb = a.in[6] + l * 1024;
    const size_t R0 = (size_t)n * 128; const int lane = C.lane, wid = C.wave, r32 = lane & 31, hi = lane >> 5;
    for (int rr = 0; rr < 16; ++rr) { const int r = wid * 16 + rr; const u32x4* p = (const u32x4*)(VB + (R0 + r) * D); const u32x4 a0 = p[lane], a1 = p[64 + lane];
        float s = 0.f, s2 = 0.f;
#pragma unroll
        for (int k = 0; k < 4; ++k) { const float x0 = bf_lo(a0[k]), x1 = bf_hi(a0[k]), x2 = bf_lo(a1[k]), x3 = bf_hi(a1[k]); s += (x0 + x1) + (x2 + x3); s2 += (x0 * x0 + x1 * x1) + (x2 * x2 + x3 * x3); }
        s = wave_sum(s); s2 = wave_sum(s2); const float mean = s * (1.f / D); const float var = fmaxf(s2 * (1.f / D) - mean * mean, 0.f);
        if (lane == 0) stats[r] = (f32x2){mean, 1.f / sqrtf(var + LN_EPS)}; }
    __syncthreads();
    const int tb = wid >> 1, ch = wid & 1;
    const int voff = ((lane >> 4) & 1) * 32 + (lane & 3) * 8 + (4 * hi + ((lane & 15) >> 2)) * 64;
    for (int g = 0; g < 8; ++g) {
#pragma unroll
        for (int j = 0; j < 4; ++j) { const int p = C.tid + 512 * j, r = p >> 4, c8 = (p & 15) * 8; const f32x2 st = stats[r];
            const u32x4 w = *(const u32x4*)(VB + (R0 + r) * D + g * 128 + c8); const f32x4 g0 = *(const f32x4*)(gam + g * 128 + c8), g1 = *(const f32x4*)(gam + g * 128 + c8 + 4);
            const f32x4 b0 = *(const f32x4*)(bet + g * 128 + c8), b1 = *(const f32x4*)(bet + g * 128 + c8 + 4);
            u32x4 o; o.x = cvt_pk_bf16((bf_lo(w.x) - st.x) * st.y * g0[0] + b0[0], (bf_hi(w.x) - st.x) * st.y * g0[1] + b0[1]);
            o.y = cvt_pk_bf16((bf_lo(w.y) - st.x) * st.y * g0[2] + b0[2], (bf_hi(w.y) - st.x) * st.y * g0[3] + b0[3]);
            o.z = cvt_pk_bf16((bf_lo(w.z) - st.x) * st.y * g1[0] + b1[0], (bf_hi(w.z) - st.x) * st.y * g1[1] + b1[1]);
            o.w = cvt_pk_bf16((bf_lo(w.w) - st.x) * st.y * g1[2] + b1[2], (bf_hi(w.w) - st.x) * st.y * g1[3] + b1[3]);
            *(LAS u32x4*)(vimg + (c8 >> 5) * 8192 + r * 64 + (c8 & 31) * 2) = o; }
        __syncthreads();
        f32x16 acc[2];
#pragma unroll
        for (int r = 0; r < 16; ++r) { acc[0][r] = 0.f; acc[1][r] = 0.f; }
        const bf16_t* wrow = SW + ((size_t)g * 128 + 32 * tb + r32) * 128 + 4 * hi;
#pragma unroll
        for (int kc = 0; kc < 8; ++kc) {
            const u32x2 alo = *(const u32x2*)(wrow + 16 * kc), ahi = *(const u32x2*)(wrow + 16 * kc + 8);
            const bf16x8 af = __builtin_bit_cast(bf16x8, (u32x4){alo.x, alo.y, ahi.x, ahi.y});
#pragma unroll
            for (int j = 0; j < 2; ++j) { LAS const unsigned char* vp = vimg + (2 * ch + j) * 8192 + kc * 1024 + voff; const s16x4 lo = att::vtr(vp), hh = att::vtr(vp + 512);
                const bf16x8 vf = (bf16x8){lo[0], lo[1], lo[2], lo[3], hh[0], hh[1], hh[2], hh[3]}; acc[j] = ATT_MFMA(af, vf, acc[j]); }
        }
        int hi_e = hi, r32_e = r32; asm volatile("" : "+v"(hi_e), "+v"(r32_e));
        const float* sbp = sb + g * 128 + 32 * tb + 4 * hi_e; bf16_t* hp = HC + (R0 + 32 * tb + 4 * hi_e) * 2048 + g * 128 + 64 * ch + r32_e;
        bf16_t uu[16][2]; float bsv[16];
#pragma unroll
        for (int r = 0; r < 16; ++r) { bsv[r] = sbp[att::crow(r, 0)];
#pragma unroll
            for (int j = 0; j < 2; ++j) uu[r][j] = hp[att::crow(r, 0) * 2048 + 32 * j]; }
        asm volatile("" ::: "memory");
#pragma unroll
        for (int r = 0; r < 16; ++r)
#pragma unroll
            for (int j = 0; j < 2; ++j) { const float u = __uint_as_float((unsigned)uu[r][j] << 16);
                hp[att::crow(r, 0) * 2048 + 32 * j] = (bf16_t)(cvt_pk_bf16(u * (acc[j][r] + bsv[r]), 0.f) & 0xffffu); }
        __syncthreads();
    }
}


#define XB_TMO      128
#define XB_XCNT(j)  (256  + 64 * (j))
#define XB_XSUB(j)  (1280 + 64 * (j))
#define XB_XGEN(j)  (2304 + 64 * (j))
#define XB_TOP      3328
#define XB_TOPGEN   3392
#define XCD_BAR_WORDS 3456
#define XB_SPIN_CAP (1u << 22)
__device__ __forceinline__ unsigned xb_ld(unsigned* p)              { return __hip_atomic_load(p, __ATOMIC_RELAXED, __HIP_MEMORY_SCOPE_AGENT); }
__device__ __forceinline__ unsigned xb_add(unsigned* p, unsigned v) { return __hip_atomic_fetch_add(p, v, __ATOMIC_RELAXED, __HIP_MEMORY_SCOPE_AGENT); }
__device__ __forceinline__ unsigned xb_xcc_id() { return (unsigned)__builtin_amdgcn_s_getreg((3 << 11) | 20) & 0xFu; }
#define XB_SPIN(cond, bar) do { unsigned _sp = 0; while (cond) { __builtin_amdgcn_s_sleep(1); \
    if ((++_sp & 255u) == 0u) { if (xb_ld(&(bar)[XB_TMO])) break; if (_sp > XB_SPIN_CAP) { atomicAdd(&(bar)[XB_TMO], 1u); break; } } } } while (0)
struct XcdBarrier { unsigned* bar; unsigned x; volatile LAS unsigned* st; };
__device__ __forceinline__ XcdBarrier xcd_barrier_post(unsigned* bar, volatile LAS unsigned* st) {
    XcdBarrier b; b.bar = bar; b.x = xb_xcc_id(); b.st = st;
    if (threadIdx.x == 0) (void)xb_add(&bar[XB_XCNT(b.x)], 1u);
    return b;
}
__device__ __forceinline__ void xcd_barrier_complete(unsigned* bar, unsigned x, unsigned& nloc, unsigned& nx) {
    const unsigned G = gridDim.x * gridDim.y * gridDim.z;
    unsigned sum, cnt, mine, sp = 0u;
    for (;;) {
        sum = 0u; cnt = 0u; mine = 0u;
#pragma unroll
        for (unsigned j = 0; j < 16; ++j) { const unsigned c = xb_ld(&bar[XB_XCNT(j)]); sum += c; cnt += (c > 0u) ? 1u : 0u; mine = (j == x) ? c : mine; }
        if (sum == G) break;
        __builtin_amdgcn_s_sleep(1);
        if ((++sp & 255u) == 0u) { if (xb_ld(&bar[XB_TMO])) break; if (sp > XB_SPIN_CAP) { atomicAdd(&bar[XB_TMO], 1u); break; } }
    }
    nloc = mine > 0u ? mine : 1u; nx = cnt > 0u ? cnt : 1u;
}
__device__ __forceinline__ void xcd_barrier(const XcdBarrier& b) {
    asm volatile("s_waitcnt vmcnt(0)" ::: "memory");
    __syncthreads();
    if (threadIdx.x == 0) {
        unsigned* bar = b.bar;
        __builtin_amdgcn_s_waitcnt(0);
        unsigned nloc = b.st[0], nx = b.st[1];
        if (nloc == 0u) { xcd_barrier_complete(bar, b.x, nloc, nx); b.st[0] = nloc; b.st[1] = nx; }
        const unsigned old = xb_add(&bar[XB_XSUB(b.x)], 1u);
        const unsigned gen = old / nloc;
        if (old + 1u == (gen + 1u) * nloc) {
            __builtin_amdgcn_fence(__ATOMIC_RELEASE, "agent");
            asm volatile("s_waitcnt vmcnt(0)" ::: "memory");
            const unsigned og = xb_add(&bar[XB_TOP], 1u);
            const unsigned tg = og / nx;
            if (og + 1u == (tg + 1u) * nx) xb_add(&bar[XB_TOPGEN], 1u);
            else XB_SPIN(xb_ld(&bar[XB_TOPGEN]) == tg, bar);
            __builtin_amdgcn_fence(__ATOMIC_ACQUIRE, "agent");
            xb_add(&bar[XB_XGEN(b.x)], 1u);
            asm volatile("s_waitcnt vmcnt(0)" ::: "memory");
        } else {
            XB_SPIN(xb_ld(&bar[XB_XGEN(b.x)]) == gen, bar);
            __builtin_amdgcn_fence(__ATOMIC_ACQUIRE, "agent");
            asm volatile("s_waitcnt vmcnt(0)" ::: "memory");
        }
    }
    __syncthreads();
}

__global__ void __launch_bounds__(512, 2) mk_fwd(Args a) {
    extern __shared__ __attribute__((aligned(16))) unsigned char lds_raw[];
    volatile LAS unsigned* bst = (volatile LAS unsigned*)((LAS unsigned char*)lds_raw + 134144);
    if (threadIdx.x < 2) bst[threadIdx.x] = 0u;
    __syncthreads();
    XcdBarrier gbar; gbar.bar = (unsigned*)a.ws; gbar.x = 0; gbar.st = bst;
    if (a.coop) gbar = xcd_barrier_post((unsigned*)a.ws, bst);
    const int G = gridDim.x, bx = blockIdx.x; const int vcu = (G % 8 == 0) ? (bx % 8) * (G / 8) + bx / 8 : bx;
    unsigned char* ws = a.ws;
    bf16_t* XB = (bf16_t*)(ws + WS_XB);
    for (int ph = a.ph_lo; ph < a.ph_hi; ++ph) {
        int tid_ = threadIdx.x; asm volatile("" : "+v"(tid_));
        Ctx C; C.lds = (LAS unsigned char*)lds_raw; C.tid = tid_; C.lane = C.tid & 63; C.wave = __builtin_amdgcn_readfirstlane(C.tid >> 6);
        C.gw = vcu * 8 + C.wave; C.NGW = G * 8;
        if (ph == 0) prologue(C, a);
        else {
            const int l = (ph - 1) / 11, s = (ph - 1) % 11;
            if (s == 0 || s == 8) {
                pg8::Gemm g{XB, (const bf16_t*)(ws + WS_WUP), T, 2 * FF, D}; pg8::StaticOrder S; S.init(T, 2 * FF, G, bx);
                pg8::EpiSwiGLU E{(bf16_t*)(ws + WS_ACT)};
                pg8::gemm_phase<pg8::EpiSwiGLU>(C.lds, g, S, E, C.tid);
            } else if (s == 1 || s == 9) {
                pg8::Gemm g{(const bf16_t*)(ws + WS_ACT), (const bf16_t*)(ws + WS_W2), T, D, FF}; pg8::StaticOrder S; S.init(T, D, G, bx);
                const bool raw = (l == 0 && s == 1); const int pli = (s == 1) ? l * 3 - 1 : l * 3 + 1;
                pg8::EpiResid E{raw ? a.in[0] : a.out, a.out, 0.5f, raw ? nullptr : (const f32x2*)(ws + WS_STATS), a.in[14] + (raw ? 0 : pli) * D, a.in[15] + (raw ? 0 : pli) * D};
                pg8::gemm_phase<pg8::EpiResid>(C.lds, g, S, E, C.tid);
            } else if (s == 2 || s == 7 || s == 10) {
                const int li = (s == 2) ? 0 : (s == 7) ? 1 : 2;
                ln_rows(C, a.out, XB, a.in[14] + (l * 3 + li) * D, a.in[15] + (l * 3 + li) * D, (f32x2*)(ws + WS_STATS), l == DEPTH - 1 && s == 10);
                if (s == 2) conv_mixer(C, a, l); else if (s == 7) conv_ffn(C, a, l, 1); else if (l + 1 < DEPTH) conv_ffn(C, a, l + 1, 0);
            } else if (s == 3) {
                pg8::Gemm g{XB, (const bf16_t*)(ws + WS_WIN), T, INW, D}; pg8::StaticOrder S; S.init(T, INW, G, bx);
                pg8::EpiInProj E{(bf16_t*)(ws + WS_HCAT), (bf16_t*)(ws + WS_V), (bf16_t*)(ws + WS_K), (bf16_t*)(ws + WS_VAL), (bf16_t*)(ws + WS_GA), (bf16_t*)(ws + WS_GB), a.in[2] + l * 2 * D, (const float*)(ws + WS_ROPE)};
                pg8::gemm_phase<pg8::EpiInProj>(C.lds, g, S, E, C.tid);
            } else if (s == 4) {
                const float* lf = a.in[7] + l * 256;
                const float s1 = wave_sum(lf[C.lane] * lf[64 + C.lane]), s2 = wave_sum(lf[128 + C.lane] * lf[192 + C.lane]);
                const float li = a.lam_init[l];
                att::Params P{(const bf16_t*)(ws + WS_HCAT) + 1024, (const bf16_t*)(ws + WS_K), (const bf16_t*)(ws + WS_VAL), (bf16_t*)(ws + WS_HCAT) + 1024, a.in[8] + l * 128, expf(s1) - expf(s2) + li, 1.0f - li};
                const int niter = (G == 256) ? 8 : (2048 + G - 1) / G;
                for (int i = 0; i < niter; ++i) {
                    int bh, qb;
                    if (G == 256) { const int base = 32 * ((i >> 1) & 1) + (vcu & 31); bh = 2 * (vcu >> 5) + (i >> 2); qb = (i & 1) ? base : 127 - base; }
                    else { const int u = bx + i * G; if (u >= 2048) break; bh = u >> 7; qb = 127 - (u & 127); }
                    att::unit(bh >> 3, bh & 7, qb, P, C.lds, C.tid);
                }
                for (int n = bx; n < 256; n += G) sgu_chunk(C, a, l, n);
            } else if (s == 5) {
                pg8::Gemm g{(const bf16_t*)(ws + WS_HCAT), (const bf16_t*)(ws + WS_WBR), T, D, 2 * D}; pg8::StaticOrder S; S.init(T, D, G, bx);
                pg8::EpiMerge E{(const bf16_t*)(ws + WS_GA), (const bf16_t*)(ws + WS_GB), (bf16_t*)(ws + WS_V)};
                pg8::gemm_phase<pg8::EpiMerge>(C.lds, g, S, E, C.tid);
            } else {
                pg8::Gemm g{(const bf16_t*)(ws + WS_V), (const bf16_t*)(ws + WS_WOUT), T, D, D}; pg8::StaticOrder S; S.init(T, D, G, bx);
                pg8::EpiResid E{a.out, a.out, 1.0f, (const f32x2*)(ws + WS_STATS), a.in[14] + (l * 3) * D, a.in[15] + (l * 3) * D};
                pg8::gemm_phase<pg8::EpiResid>(C.lds, g, S, E, C.tid);
            }
        }
        if (ph + 1 < a.ph_hi) { if (a.coop) { if (ph == a.ph_lo) cg::this_grid().sync(); else xcd_barrier(gbar); } }
    }
}

constexpr int LDS_BYTES = 135168;

extern "C" void kernel_launch(void* const* d_in, const int* in_sizes, int n_in, void* d_out, int out_size, void* d_ws, size_t ws_size, hipStream_t stream) {
    static int grid = 0;
    if (grid == 0) {
        if (n_in != 16 || out_size != T * D || ws_size < WS_END) { fprintf(stderr, "kernel_launch: unexpected shapes (n_in %d out %d ws %zu need %zu)\n", n_in, out_size, ws_size, (size_t)WS_END); grid = -1; return; }
        int dev = 0, cus = 0, per_cu = 0;
        hipGetDevice(&dev); hipDeviceGetAttribute(&cus, hipDeviceAttributeMultiprocessorCount, dev);
        if (hipFuncSetAttribute((const void*)mk_fwd, hipFuncAttributeMaxDynamicSharedMemorySize, LDS_BYTES) != hipSuccess) { fprintf(stderr, "kernel_launch: hipFuncSetAttribute failed\n"); grid = -1; return; }
        if (hipOccupancyMaxActiveBlocksPerMultiprocessor(&per_cu, (const void*)mk_fwd, 512, LDS_BYTES) != hipSuccess || per_cu < 1) per_cu = 1;
        (void)hipGetLastError();
        grid = cus * per_cu;
    }
    if (grid < 0) return;
    (void)hipMemsetAsync(d_ws, 0, 16384, stream);
    Args a{};
    for (int i = 0; i < 16; ++i) a.in[i] = (const float*)d_in[i];
    a.out = (float*)d_out; a.ws = (unsigned char*)d_ws;
    for (int j = 0; j < 32; ++j) a.invf[j] = (float)pow(10000.0, -(double)j / 32.0);
    for (int l = 0; l < DEPTH; ++l) a.lam_init[l] = (float)(0.8 - 0.6 * exp(-0.3 * (double)l));
#if MK_COOP
    a.ph_lo = 0; a.ph_hi = NPH; a.coop = 1;
    void* args[] = {&a};
    hipError_t e = hipLaunchCooperativeKernel((const void*)mk_fwd, dim3(grid), dim3(512), args, LDS_BYTES, stream);
    if (e != hipSuccess) fprintf(stderr, "cooperative launch failed: %s (grid %d)\n", hipGetErrorString(e), grid);
#else
    a.coop = 0;
    for (int ph = 0; ph < NPH; ++ph) { a.ph_lo = ph; a.ph_hi = ph + 1; hipLaunchKernelGGL(mk_fwd, dim3(grid), dim3(512), LDS_BYTES, stream, a); }
#endif
}
```
